# Optimizing an MI355X kernel written in HIP

```python
import jax, jax.numpy as jnp
from jax import lax
import numpy as np

D_MODEL = 2048
BATCH = 16
SEQ = 256
DEPTH = 4
DEC_BATCH = 4
DEC_SEQ = 1024
PAST_LEN = 256

GRID_W = 64
HEAD_DIM = 128
A_HEADS = 8
A_KV_HEADS = 2
A_WINDOW = 128
A_BLOCK = 128
B_HEADS = 8
NA_ROWS_MAX = 8
NA_COLS = 16
NA_QCOLS = 16
NA_KCOLS = 32
C_HEADS = 8
C_DK = D_MODEL // C_HEADS
C_DV = D_MODEL // C_HEADS
C_CHUNK = 128
Q_BLOCK = 128
ROPE_THETA = 10000.0
EPS = 1e-6

N_EVEN = (DEPTH + 1) // 2
N_ODD = DEPTH // 2
A_Q = A_HEADS * HEAD_DIM
A_KV = A_KV_HEADS * HEAD_DIM
B_W = B_HEADS * HEAD_DIM
EVEN_WIDTH = A_Q + B_W
EVEN_IN = A_Q + 2 * A_KV + 3 * B_W + EVEN_WIDTH
C_WIDTH = C_HEADS * C_DV
ODD_IN = 2 * C_HEADS * C_DK + 2 * C_WIDTH
RPB_R = 2 * NA_ROWS_MAX - 1
RPB_C = 2 * NA_COLS - 1

kernel_name = "hybrid_diffusion_prefix_step"


def rmsnorm(x, g):
    xf = x.astype(jnp.float32)
    y = xf * lax.rsqrt(jnp.mean(xf * xf, axis=-1, keepdims=True) + EPS)
    return (y * g.astype(jnp.float32)).astype(x.dtype)


def adaln(cvec, w, b):
    mod = jax.nn.silu(cvec) @ w + b
    return jnp.split(mod, 3, axis=-1)


def _rot(x, ang):
    n = x.shape[-1] // 2
    cos = jnp.cos(ang)[None, :, None, :]
    sin = jnp.sin(ang)[None, :, None, :]
    x1, x2 = x[..., :n], x[..., n:]
    return jnp.concatenate([x1 * cos - x2 * sin, x2 * cos + x1 * sin], axis=-1)


def axial_rope(x):
    T = x.shape[1]
    t = jnp.arange(T)
    half = HEAD_DIM // 2
    nf = half // 2
    inv = ROPE_THETA ** (-jnp.arange(nf, dtype=jnp.float32) / nf)
    ang_r = (t // GRID_W).astype(jnp.float32)[:, None] * inv[None]
    ang_c = (t % GRID_W).astype(jnp.float32)[:, None] * inv[None]
    xf = x.astype(jnp.float32)
    return jnp.concatenate([_rot(xf[..., :half], ang_r), _rot(xf[..., half:], ang_c)], axis=-1).astype(x.dtype)


def context_attention(q, k, v, sink):
    B, T, H, hd = q.shape
    Hkv, Tk = k.shape[1], k.shape[2]
    G = H // Hkv
    nqb = T // Q_BLOCK
    qb = q.reshape(B, nqb, Q_BLOCK, Hkv, G, hd).transpose(1, 0, 2, 3, 4, 5)
    scale = hd ** -0.5

    def block(qi):
        s = jnp.einsum('bqngd,bnkd->bngqk', qi, k).astype(jnp.float32) * scale
        if sink is not None:
            sk = jnp.broadcast_to(sink.reshape(Hkv, G).astype(jnp.float32)[None, :, :, None, None], s.shape[:-1] + (1,))
            s = jnp.concatenate([s, sk], axis=-1)
        p = jax.nn.softmax(s, axis=-1)[..., :Tk].astype(v.dtype)
        return jnp.einsum('bngqk,bnkd->bqngd', p, v).reshape(B, Q_BLOCK, H * hd)

    o = lax.map(block, qb)
    return o.transpose(1, 0, 2, 3).reshape(B, T, H * hd)


def window_attention(q, k, v, ck, cv, sink):
    B, T, H, hd = q.shape
    Hkv = k.shape[2]
    G = H // Hkv
    nb = T // A_BLOCK
    P = ck.shape[2]
    scale = hd ** -0.5

    def band(x):
        xp = jnp.pad(x, ((0, 0), (A_BLOCK, A_BLOCK), (0, 0), (0, 0))).reshape(B, nb + 2, A_BLOCK, Hkv, hd)
        return jnp.concatenate([xp[:, :-2], xp[:, 1:-1], xp[:, 2:]], axis=2)

    kw, vw = band(k), band(v)
    qb = q.reshape(B, nb, A_BLOCK, Hkv, G, hd)
    blk = jnp.arange(nb)[:, None]
    qpos = blk * A_BLOCK + jnp.arange(A_BLOCK)[None]
    kpos = (blk - 1) * A_BLOCK + jnp.arange(3 * A_BLOCK)[None]
    valid = ((jnp.abs(qpos[:, :, None] - kpos[:, None, :]) <= A_WINDOW)
             & (kpos[:, None, :] >= 0) & (kpos[:, None, :] < T))
    s_w = jnp.einsum('bjqngd,bjknd->bjngqk', qb, kw).astype(jnp.float32) * scale
    s_w = jnp.where(valid[None, :, None, None], s_w, -jnp.inf)
    s_c = jnp.einsum('bjqngd,bnkd->bjngqk', qb, ck).astype(jnp.float32) * scale
    s_sink = jnp.broadcast_to(sink.reshape(Hkv, G).astype(jnp.float32)[None, None, :, :, None, None], s_c.shape[:-1] + (1,))
    p = jax.nn.softmax(jnp.concatenate([s_c, s_w, s_sink], axis=-1), axis=-1)
    pc = p[..., :P].astype(v.dtype)
    pw = p[..., P:P + 3 * A_BLOCK].astype(v.dtype)
    o = jnp.einsum('bjngqk,bnkd->bjqngd', pc, cv) + jnp.einsum('bjngqk,bjknd->bjqngd', pw, vw)
    return o.reshape(B, T, H * hd)


def neighbourhood_attention(q, k, v, ck, cv, rpb):
    B, T, H, hd = q.shape
    rows = T // GRID_W
    wr = min(NA_ROWS_MAX, rows)
    ncb = GRID_W // NA_QCOLS
    scale = hd ** -0.5
    r = jnp.arange(rows)
    r0 = jnp.clip(r - wr // 2, 0, rows - wr)
    krow = r0[:, None] + jnp.arange(wr)[None]
    m = jnp.arange(ncb)
    cs = jnp.clip(m * NA_QCOLS - NA_COLS // 2, 0, GRID_W - NA_KCOLS)
    kcol = cs[:, None] + jnp.arange(NA_KCOLS)[None]
    qc = m[:, None] * NA_QCOLS + jnp.arange(NA_QCOLS)[None]
    c0 = jnp.clip(qc - NA_COLS // 2, 0, GRID_W - NA_COLS)
    colmask = (kcol[:, None, :] >= c0[:, :, None]) & (kcol[:, None, :] < c0[:, :, None] + NA_COLS)
    dr_idx = krow - r[:, None] + (NA_ROWS_MAX - 1)
    dc_idx = jnp.clip(kcol[:, None, :] - qc[:, :, None] + (NA_COLS - 1), 0, RPB_C - 1)
    bias = rpb[:, dr_idx[:, None, None, :, None], dc_idx[None, :, :, None, :]].astype(jnp.float32)
    bias = jnp.where(colmask[None, None, :, :, None, :], bias, -jnp.inf)
    bias = bias.reshape(H, rows, ncb, NA_QCOLS, wr * NA_KCOLS).transpose(1, 2, 0, 3, 4)

    def gather(x):
        xg = x.reshape(B, rows, GRID_W, H, hd)
        xn = xg[:, krow[:, None, :, None], kcol[None, :, None, :]]
        return xn.reshape(B, rows, ncb, wr * NA_KCOLS, H, hd)

    kn, vn = gather(k), gather(v)
    qg = q.reshape(B, rows, ncb, NA_QCOLS, H, hd)
    P = ck.shape[2]
    s_n = jnp.einsum('brmqhd,brmkhd->brmhqk', qg, kn).astype(jnp.float32) * scale + bias[None]
    s_c = jnp.einsum('brmqhd,bhkd->brmhqk', qg, ck).astype(jnp.float32) * scale
    p = jax.nn.softmax(jnp.concatenate([s_c, s_n], axis=-1), axis=-1)
    pc = p[..., :P].astype(v.dtype)
    pn = p[..., P:].astype(v.dtype)
    o = jnp.einsum('brmhqk,bhkd->brmqhd', pc, cv) + jnp.einsum('brmhqk,brmkhd->brmqhd', pn, vn)
    return o.reshape(B, T, H * hd)


def _even_split(h, w_in):
    B, T = h.shape[:2]
    proj = h @ w_in
    idx = np.cumsum([A_Q, A_KV, A_KV, B_W, B_W, B_W])
    qa, ka, va, qb, kb, vb, gate = jnp.split(proj, idx, axis=-1)
    qa = qa.reshape(B, T, A_HEADS, HEAD_DIM)
    ka = ka.reshape(B, T, A_KV_HEADS, HEAD_DIM)
    va = va.reshape(B, T, A_KV_HEADS, HEAD_DIM)
    qb = qb.reshape(B, T, B_HEADS, HEAD_DIM)
    kb = kb.reshape(B, T, B_HEADS, HEAD_DIM)
    vb = vb.reshape(B, T, B_HEADS, HEAD_DIM)
    return qa, ka, va, qb, kb, vb, gate


def even_context(h, w_in, w_out, sink):
    qa, ka, va, qb, kb, vb, gate = _even_split(h, w_in)
    ka, va, kb, vb = (x.transpose(0, 2, 1, 3) for x in (ka, va, kb, vb))
    oa = context_attention(qa, ka, va, sink)
    ob = context_attention(qb, kb, vb, None)
    out = (jnp.concatenate([oa, ob], axis=-1) * jax.nn.silu(gate)) @ w_out
    return out, ka, va, kb, vb


def even_latent(h, w_in, w_out, sink, rpb, ck_a, cv_a, ck_b, cv_b):
    qa, ka, va, qb, kb, vb, gate = _even_split(h, w_in)
    qa, ka = axial_rope(qa), axial_rope(ka)
    oa = window_attention(qa, ka, va, ck_a, cv_a, sink)
    ob = neighbourhood_attention(qb, kb, vb, ck_b, cv_b, rpb)
    return (jnp.concatenate([oa, ob], axis=-1) * jax.nn.silu(gate)) @ w_out


def retention_scan(q, k, v, log_g, s0):
    B, T, H, dk = q.shape
    dv = v.shape[-1]
    nc = T // C_CHUNK

    def chunks(x):
        return x.astype(jnp.float32).reshape(B, nc, C_CHUNK, H, x.shape[-1]).transpose(1, 0, 2, 3, 4)

    qc, kc, vc = chunks(q), chunks(k), chunks(v)
    i = jnp.arange(C_CHUNK, dtype=jnp.float32)
    diff = i[:, None] - i[None, :]
    dmat = jnp.where(diff >= 0, jnp.exp(log_g[:, None, None] * jnp.maximum(diff, 0.0)), 0.0)
    q_dec = jnp.exp(log_g[None, :] * (i[:, None] + 1.0))
    k_dec = jnp.exp(log_g[None, :] * (C_CHUNK - 1.0 - i[:, None]))
    chunk_dec = jnp.exp(log_g * C_CHUNK)

    def step(S, inp):
        qi, ki, vi = inp
        s = jnp.einsum('bihd,bjhd->bhij', qi, ki) * dmat[None]
        inner = jnp.einsum('bhij,bjhe->bihe', s, vi)
        cross = jnp.einsum('bihd,bhde->bihe', qi, S) * q_dec[None, :, :, None]
        S_new = S * chunk_dec[None, :, None, None] + jnp.einsum('bjhd,bjhe->bhde', ki * k_dec[None, :, :, None], vi)
        return S_new, inner + cross

    S_fin, outs = lax.scan(step, s0.astype(jnp.float32), (qc, kc, vc))
    return outs.transpose(1, 0, 2, 3, 4).reshape(B, T, H, dv), S_fin


def retention_mixer(h, w_in, w_out, dec_f, dec_b, gn_g, s_f0, s_b0):
    B, T = h.shape[:2]
    q, k, v, gate = jnp.split(h @ w_in, 4, axis=-1)
    q = q.reshape(B, T, C_HEADS, C_DK)
    k = k.reshape(B, T, C_HEADS, C_DK) * (C_DK ** -0.5)
    v = v.reshape(B, T, C_HEADS, C_DV)
    log_f = -jnp.exp(dec_f.astype(jnp.float32))
    log_b = -jnp.exp(dec_b.astype(jnp.float32))
    o_f, S_f = retention_scan(q, k, v, log_f, s_f0)
    o_bf, S_b = retention_scan(jnp.flip(q, 1), jnp.flip(k, 1), jnp.flip(v, 1), log_b, s_b0)
    o = o_f + jnp.flip(o_bf, 1)
    mu = jnp.mean(o, axis=-1, keepdims=True)
    var = jnp.mean((o - mu) ** 2, axis=-1, keepdims=True)
    o = ((o - mu) * lax.rsqrt(var + EPS)).reshape(B, T, C_WIDTH) * gn_g.astype(jnp.float32)
    out = (o.astype(h.dtype) * jax.nn.silu(gate)) @ w_out
    return out, S_f, S_b


def setup_inputs(seed: int = 0) -> dict:
    key = jax.random.key(seed)
    ks = jax.random.split(key, 24)
    f32 = jnp.float32
    nrm = lambda k, shape, s: jax.random.normal(k, shape, f32) * s
    base_dec = jnp.log(-jnp.log1p(-(2.0 ** (-5.0 - jnp.arange(C_HEADS, dtype=f32)))))
    return {
        "x_prompt": nrm(ks[0], (BATCH, SEQ, D_MODEL), 1.0),
        "x_sample": nrm(ks[1], (DEC_BATCH, DEC_SEQ, D_MODEL), 1.0),
        "c": nrm(ks[2], (DEC_BATCH, D_MODEL), 1.0),
        "cache_a_k": nrm(ks[3], (DEC_BATCH, N_EVEN, A_KV_HEADS, PAST_LEN, HEAD_DIM), 1.0),
        "cache_a_v": nrm(ks[4], (DEC_BATCH, N_EVEN, A_KV_HEADS, PAST_LEN, HEAD_DIM), 1.0),
        "cache_b_k": nrm(ks[5], (DEC_BATCH, N_EVEN, B_HEADS, PAST_LEN, HEAD_DIM), 1.0),
        "cache_b_v": nrm(ks[6], (DEC_BATCH, N_EVEN, B_HEADS, PAST_LEN, HEAD_DIM), 1.0),
        "state_ret_f": nrm(ks[7], (DEC_BATCH, N_ODD, C_HEADS, C_DK, C_DV), 0.5),
        "state_ret_b": nrm(ks[8], (DEC_BATCH, N_ODD, C_HEADS, C_DK, C_DV), 0.5),
        "c_ctx": nrm(ks[9], (D_MODEL,), 1.0),
        "w_ada": nrm(ks[10], (DEPTH, D_MODEL, 3 * D_MODEL), 0.5 * D_MODEL ** -0.5),
        "b_ada": nrm(ks[11], (DEPTH, 3 * D_MODEL), 0.01),
        "norm_pre": 1.0 + nrm(ks[12], (DEPTH, D_MODEL), 0.05),
        "norm_post": 1.0 + nrm(ks[13], (DEPTH, D_MODEL), 0.05),
        "w_in_even": nrm(ks[14], (N_EVEN, D_MODEL, EVEN_IN), D_MODEL ** -0.5),
        "w_out_even": nrm(ks[15], (N_EVEN, EVEN_WIDTH, D_MODEL), EVEN_WIDTH ** -0.5),
        "a_sink": nrm(ks[16], (N_EVEN, A_HEADS), 0.5),
        "na_rpb": nrm(ks[17], (N_EVEN, B_HEADS, RPB_R, RPB_C), 0.1),
        "w_in_odd": nrm(ks[18], (N_ODD, D_MODEL, ODD_IN), D_MODEL ** -0.5),
        "w_out_odd": nrm(ks[19], (N_ODD, C_WIDTH, D_MODEL), C_WIDTH ** -0.5),
        "ret_decay_f": base_dec[None] + nrm(ks[20], (N_ODD, C_HEADS), 0.1),
        "ret_decay_b": base_dec[None] + nrm(ks[21], (N_ODD, C_HEADS), 0.1),
        "ret_gn": 1.0 + nrm(ks[22], (N_ODD, C_WIDTH), 0.05),
    }


def reference(x_prompt, x_sample, c, cache_a_k, cache_a_v, cache_b_k, cache_b_v, state_ret_f, state_ret_b,
              c_ctx, w_ada, b_ada, norm_pre, norm_post, w_in_even, w_out_even, a_sink, na_rpb,
              w_in_odd, w_out_odd, ret_decay_f, ret_decay_b, ret_gn):
    xp, xs = x_prompt, x_sample
    zero_state = jnp.zeros((x_prompt.shape[0], C_HEADS, C_DK, C_DV), jnp.float32)
    new_ak, new_av, new_bk, new_bv, new_sf, new_sb = [], [], [], [], [], []
    for l in range(DEPTH):
        i = l // 2
        sh_p, sc_p, g_p = adaln(c_ctx[None, :], w_ada[l], b_ada[l])
        sh_s, sc_s, g_s = adaln(c, w_ada[l], b_ada[l])
        hp = rmsnorm(xp, norm_pre[l]) * (1.0 + sc_p[:, None]) + sh_p[:, None]
        hs = rmsnorm(xs, norm_pre[l]) * (1.0 + sc_s[:, None]) + sh_s[:, None]
        if l % 2 == 0:
            op, ka, va, kb, vb = even_context(hp, w_in_even[i], w_out_even[i], a_sink[i])
            os_ = even_latent(hs, w_in_even[i], w_out_even[i], a_sink[i], na_rpb[i],
                              cache_a_k[:, i], cache_a_v[:, i], cache_b_k[:, i], cache_b_v[:, i])
            new_ak.append(ka)
            new_av.append(va)
            new_bk.append(kb)
            new_bv.append(vb)
        else:
            op, sf, sb = retention_mixer(hp, w_in_odd[i], w_out_odd[i], ret_decay_f[i], ret_decay_b[i],
                                         ret_gn[i], zero_state, zero_state)
            os_, _, _ = retention_mixer(hs, w_in_odd[i], w_out_odd[i], ret_decay_f[i], ret_decay_b[i],
                                        ret_gn[i], state_ret_f[:, i], state_ret_b[:, i])
            new_sf.append(sf)
            new_sb.append(sb)
        xp = xp + g_p[:, None] * rmsnorm(op, norm_post[l])
        xs = xs + g_s[:, None] * rmsnorm(os_, norm_post[l])
    new_a_k = jnp.stack(new_ak, axis=1)
    new_a_v = jnp.stack(new_av, axis=1)
    new_b_k = jnp.stack(new_bk, axis=1)
    new_b_v = jnp.stack(new_bv, axis=1)
    new_ret_f = jnp.stack(new_sf, axis=1)
    new_ret_b = jnp.stack(new_sb, axis=1)
    return (xp, xs, new_a_k, new_a_v, new_b_k, new_b_v, new_ret_f, new_ret_b)
```

```cpp
#include <hip/hip_runtime.h>
#include <hip/hip_cooperative_groups.h>
#include <cstdio>
#include <cstdint>
namespace cg = cooperative_groups;

#ifndef MULTI_LAUNCH
#define MULTI_LAUNCH 0
#endif

#define LAS __attribute__((address_space(3)))
typedef unsigned short bf16_t;
typedef short bf16x8 __attribute__((ext_vector_type(8)));
typedef short s16x4 __attribute__((ext_vector_type(4)));
typedef float f32x4 __attribute__((ext_vector_type(4)));
typedef unsigned u32x2 __attribute__((ext_vector_type(2)));
typedef unsigned u32x4 __attribute__((ext_vector_type(4)));

constexpr int DM = 2048, NTOK = 8192, NPT = 4096, EIN = 6656, OIN = 8192;
constexpr int LDK = 2112, LDPE = 6720, LDPO = 8256;
constexpr float EPSV = 1e-6f;
constexpr float LOG2E = 1.4426950408889634f;
constexpr size_t O_AK = 16777216, O_AV = 18874368, O_BK = 20971520, O_BV = 29360128, O_RF = 37748736, O_RB = 54525952;
constexpr size_t WS_WIE = 0;
constexpr size_t WS_WOE = WS_WIE + (size_t)2 * EIN * LDK * 2;
constexpr size_t WS_WIO = WS_WOE + (size_t)2 * DM * LDK * 2;
constexpr size_t WS_WOO = WS_WIO + (size_t)2 * OIN * LDK * 2;
constexpr size_t WS_H = WS_WOO + (size_t)2 * DM * LDK * 2;
constexpr size_t WS_PROJ = WS_H + (size_t)NTOK * LDK * 2;
constexpr size_t WS_MIX = WS_PROJ + (size_t)NTOK * LDPO * 2;
constexpr size_t WS_OUT = WS_MIX + (size_t)NTOK * LDK * 2;
constexpr size_t WS_OF = WS_OUT + (size_t)NTOK * LDK * 2;
constexpr size_t WS_OB = WS_OF + (size_t)NTOK * LDK * 2;
constexpr size_t WS_MODP = WS_OB + (size_t)NTOK * LDK * 2;
constexpr size_t WS_MOD = WS_MODP + (size_t)8 * 4 * 5 * 6144 * 4;
constexpr size_t WS_ROPE = WS_MOD + (size_t)4 * 5 * 6144 * 4;
constexpr size_t WS_BAR = WS_ROPE + 64 * 32 * 2 * 4;
constexpr size_t WS_XB = WS_BAR + 3456 * 4;
constexpr size_t WS_END = WS_XB + (size_t)NTOK * LDK * 2;

constexpr int LDS_BYTES = 151552;
constexpr int NPHASE = 23;

struct Params {
    const float* in[23];
    float* out;
    unsigned char* ws;
    int ph_lo, ph_hi;
};

__device__ __forceinline__ unsigned cvt_pk_bf16(float lo, float hi) { unsigned r; asm("v_cvt_pk_bf16_f32 %0, %1, %2" : "=v"(r) : "v"(lo), "v"(hi)); return r; }
__device__ __forceinline__ unsigned short f2bf(float f) { return (unsigned short)(cvt_pk_bf16(f, 0.f) & 0xffffu); }
__device__ __forceinline__ float bf2f(short b) { return __uint_as_float(((unsigned)(unsigned short)b) << 16); }
__device__ __forceinline__ int otid() { int t = threadIdx.x; asm volatile("" : "+v"(t)); return t; }
__device__ __forceinline__ float wave_sum(float v) {
#pragma unroll
    for (int o = 32; o; o >>= 1) v += __shfl_xor(v, o);
    return v;
}
__device__ __forceinline__ float silu_f(float v) { return v / (1.f + __expf(-v)); }
__device__ __forceinline__ float ex2(float v) { return __builtin_amdgcn_exp2f(v); }
__device__ __forceinline__ bf16x8 cvt8(const float* p) {
    f32x4 a = *(const f32x4*)p, b = *(const f32x4*)(p + 4);
    u32x4 w = {cvt_pk_bf16(a[0], a[1]), cvt_pk_bf16(a[2], a[3]), cvt_pk_bf16(b[0], b[1]), cvt_pk_bf16(b[2], b[3])};
    return __builtin_bit_cast(bf16x8, w);
}
__device__ __forceinline__ bf16x8 pack8(f32x4 a, f32x4 b) {
    u32x4 w = {cvt_pk_bf16(a[0], a[1]), cvt_pk_bf16(a[2], a[3]), cvt_pk_bf16(b[0], b[1]), cvt_pk_bf16(b[2], b[3])};
    return __builtin_bit_cast(bf16x8, w);
}
__device__ __forceinline__ bf16x8 tr2(LAS unsigned char* a0, LAS unsigned char* a1) {
    s16x4 x = __builtin_amdgcn_ds_read_tr16_b64_v4i16((LAS s16x4*)a0);
    s16x4 y = __builtin_amdgcn_ds_read_tr16_b64_v4i16((LAS s16x4*)a1);
    bf16x8 r = {x[0], x[1], x[2], x[3], y[0], y[1], y[2], y[3]};
    return r;
}

#define XB_TMO      128
#define XB_XCNT(j)  (256  + 64 * (j))
#define XB_XSUB(j)  (1280 + 64 * (j))
#define XB_XGEN(j)  (2304 + 64 * (j))
#define XB_TOP      3328
#define XB_TOPGEN   3392
#define XCD_BAR_WORDS 3456
#define XB_SPIN_CAP (1u << 18)
__device__ __forceinline__ unsigned xb_ld(unsigned* p)              { return __hip_atomic_load(p, __ATOMIC_RELAXED, __HIP_MEMORY_SCOPE_AGENT); }
__device__ __forceinline__ unsigned xb_add(unsigned* p, unsigned v) { return __hip_atomic_fetch_add(p, v, __ATOMIC_RELAXED, __HIP_MEMORY_SCOPE_AGENT); }
__device__ __forceinline__ unsigned xb_xcc_id() { return (unsigned)__builtin_amdgcn_s_getreg((3 << 11) | 20) & 0xFu; }
#define XB_SPIN(cond, bar) do { unsigned _sp = 0; while (cond) { __builtin_amdgcn_s_sleep(1); \
    if ((++_sp & 255u) == 0u) { if (xb_ld(&(bar)[XB_TMO])) break; if (_sp > XB_SPIN_CAP) { atomicAdd(&(bar)[XB_TMO], 1u); break; } } } } while (0)
struct XcdBarrier { unsigned* bar; unsigned x; volatile LAS unsigned* st; };
__device__ __forceinline__ XcdBarrier xcd_barrier_post(unsigned* bar, volatile LAS unsigned* st) {
    XcdBarrier b; b.bar = bar; b.x = xb_xcc_id(); b.st = st;
    if (threadIdx.x == 0) (void)xb_add(&bar[XB_XCNT(b.x)], 1u);
    return b;
}
__device__ __forceinline__ void xcd_barrier_complete(unsigned* bar, unsigned x, unsigned& nloc, unsigned& nx) {
    const unsigned G = gridDim.x * gridDim.y * gridDim.z;
    unsigned sum, cnt, mine, sp = 0u;
    for (;;) {
        sum = 0u; cnt = 0u; mine = 0u;
#pragma unroll
        for (unsigned j = 0; j < 16; ++j) { const unsigned c = xb_ld(&bar[XB_XCNT(j)]); sum += c; cnt += (c > 0u) ? 1u : 0u; mine = (j == x) ? c : mine; }
        if (sum == G) break;
        __builtin_amdgcn_s_sleep(1);
        if ((++sp & 255u) == 0u) { if (xb_ld(&bar[XB_TMO])) break; if (sp > XB_SPIN_CAP) { atomicAdd(&bar[XB_TMO], 1u); break; } }
    }
    nloc = mine > 0u ? mine : 1u; nx = cnt > 0u ? cnt : 1u;
}
__device__ __forceinline__ void xcd_barrier(const XcdBarrier& b) {
    asm volatile("s_waitcnt vmcnt(0)" ::: "memory");
    __syncthreads();
    if (threadIdx.x == 0) {
        unsigned* bar = b.bar;
        __builtin_amdgcn_s_waitcnt(0);
        unsigned nloc = b.st[0], nx = b.st[1];
        if (nloc == 0u) { xcd_barrier_complete(bar, b.x, nloc, nx); b.st[0] = nloc; b.st[1] = nx; }
        const unsigned old = xb_add(&bar[XB_XSUB(b.x)], 1u);
        const unsigned gen = old / nloc;
        if (old + 1u == (gen + 1u) * nloc) {
            __builtin_amdgcn_fence(__ATOMIC_RELEASE, "agent");
            asm volatile("s_waitcnt vmcnt(0)" ::: "memory");
            const unsigned og = xb_add(&bar[XB_TOP], 1u);
            const unsigned tg = og / nx;
            if (og + 1u == (tg + 1u) * nx) xb_add(&bar[XB_TOPGEN], 1u);
            else XB_SPIN(xb_ld(&bar[XB_TOPGEN]) == tg, bar);
            __builtin_amdgcn_fence(__ATOMIC_ACQUIRE, "agent");
            xb_add(&bar[XB_XGEN(b.x)], 1u);
            asm volatile("s_waitcnt vmcnt(0)" ::: "memory");
        } else {
            XB_SPIN(xb_ld(&bar[XB_XGEN(b.x)]) == gen, bar);
            __builtin_amdgcn_fence(__ATOMIC_ACQUIRE, "agent");
            asm volatile("s_waitcnt vmcnt(0)" ::: "memory");
        }
    }
    __syncthreads();
}

namespace pg8 {
constexpr int BM = 256, BK = 64, HALF = 128, HTB = HALF * BK * 2, STAGE_BYTES = 8 * HTB, NXCD = 8, WGM = 4;
__device__ __forceinline__ int lds_byte(int r, int c) { const int st = (r >> 4) * 2 + (c >> 5), rr = r & 15, cc = c & 31, ob = rr * 64 + cc * 2; return st * 1024 + (ob ^ (((ob >> 9) & 1) << 5)); }
__device__ __forceinline__ void stage_rc(int b, int& R, int& C) { const int st = b / 1024, sb = b % 1024, swz = sb ^ (((sb >> 9) & 1) << 5); R = (st >> 1) * 16 + swz / 64; C = (st & 1) * 32 + (swz % 64) / 2; }
__device__ __forceinline__ int perm32(int rho) { const int n = rho >> 4, i = rho & 15; return 8 * (i >> 2) + 4 * n + (i & 3); }
struct Unit { int pm, pn; };
struct Gemm { const bf16_t* A; const bf16_t* Bt; int M, N, K, ld; };
struct StaticOrder {
    int nM, nN, nwg, G, c;
    __device__ void init(int M, int N, int G_, int c_) { nM = M / BM; nN = N / BM; nwg = nM * nN; G = G_; c = c_; }
    __device__ bool next(int i, Unit& u) const {
        const long L = (long)i * G + c; if (L >= nwg) return false;
        int wgid = (int)L; { const int q = nwg / NXCD, r = nwg % NXCD, xcd = wgid % NXCD, off = wgid / NXCD; wgid = (xcd < r ? xcd * (q + 1) : r * (q + 1) + (xcd - r) * q) + off; }
        const int nig = WGM * nN, gid = wgid / nig, fm = gid * WGM, gsz = (nM - fm) < WGM ? (nM - fm) : WGM;
        u.pm = fm + ((wgid % nig) % gsz); u.pn = (wgid % nig) / gsz; return true;
    }
};

struct Epi {
    int mode;
    void* C; int ldc; float* out; int li;
    __device__ __forceinline__ void operator()(const f32x4 (&acc)[2][2][4][2], const Unit& u, int wr, int wc, int fr, int fq) const {
        const int row0 = u.pm * BM + wr * 64 + fr, col0 = u.pn * BM + wc * 32 + 8 * fq;
#pragma unroll
        for (int ai = 0; ai < 2; ++ai)
#pragma unroll
            for (int m = 0; m < 4; ++m) { bf16_t* rowp = (bf16_t*)C + (size_t)(row0 + ai * HALF + m * 16) * ldc + col0;
#pragma unroll
                for (int bj = 0; bj < 2; ++bj) { const f32x4 v0 = acc[ai][bj][m][0], v1 = acc[ai][bj][m][1];
                    u32x4 w = {cvt_pk_bf16(v0[0], v0[1]), cvt_pk_bf16(v0[2], v0[3]), cvt_pk_bf16(v1[0], v1[1]), cvt_pk_bf16(v1[2], v1[3])}; *(u32x4*)(rowp + bj * HALF) = w; } }
        if (mode == 1 && u.pm < 16) {
            const int pn = u.pn; float* base = nullptr; int c0 = 0, nh = 2;
            if (pn == 4) { base = out + O_AK; c0 = 1024; nh = 2; }
            else if (pn == 5) { base = out + O_AV; c0 = 1280; nh = 2; }
            else if (pn >= 10 && pn < 14) { base = out + O_BK; c0 = 2560; nh = 8; }
            else if (pn >= 14 && pn < 18) { base = out + O_BV; c0 = 3584; nh = 8; }
            if (base) {
                const int b = u.pm;
#pragma unroll
                for (int ai = 0; ai < 2; ++ai)
#pragma unroll
                    for (int m = 0; m < 4; ++m) { const int t = wr * 64 + fr + ai * HALF + m * 16;
#pragma unroll
                        for (int bj = 0; bj < 2; ++bj)
#pragma unroll
                            for (int n = 0; n < 2; ++n) { const int c2 = col0 + bj * HALF + 4 * n - c0; const int hh = c2 >> 7, d = c2 & 127;
                                *(f32x4*)(base + ((size_t)((b * 2 + li) * nh + hh) * 256 + t) * 128 + d) = acc[ai][bj][m][n]; } }
            }
        }
    }
};

__device__ __forceinline__ void gemm_phase(LAS unsigned char* lds, const Gemm g, const StaticOrder& S, const Epi& E) {
    const int tid = otid(), wid = __builtin_amdgcn_readfirstlane(tid >> 6), lane = tid & 63, wr = wid >> 2, wc = wid & 3, fr = lane & 15, fq = lane >> 4;
    const int K = g.ld, nt = g.K / BK;
    unsigned voffA[2], voffB[2];
#pragma unroll
    for (int i = 0; i < 2; ++i) { int R, C; stage_rc(tid * 16 + i * 8192, R, C); const int Rb = (R & ~31) + perm32(R & 31); voffA[i] = (unsigned)(R * K + C) * 2u; voffB[i] = (unsigned)(Rb * K + C) * 2u; }
    const size_t kstep = (size_t)(BK * 2);
    const size_t hstep = (size_t)HALF * K * 2;
    const size_t tstep = 2 * hstep;
    const unsigned ldsw = (unsigned)wid * 1024u;
    const int aoff = lds_byte(wr * 64 + fr, fq * 8), boff = lds_byte(wc * 32 + fr, fq * 8);
#define PG8_SA(b, h) (((b) * 2 + (h)) * HTB)
#define PG8_SB(b, h) ((4 + (b) * 2 + (h)) * HTB)
#define PG8_STAGE(bufoff, gbase, voff) do { _Pragma("unroll") for (int _i = 0; _i < 2; ++_i) \
        __builtin_amdgcn_global_load_lds((const unsigned*)((const char*)(gbase) + (voff)[_i]), (LAS unsigned*)(lds + (bufoff) + ldsw + _i * 8192), 16, 0, 0); } while (0)
#define PG8_LDA(dst, b, h) do { _Pragma("unroll") for (int m = 0; m < 4; ++m) _Pragma("unroll") for (int k = 0; k < 2; ++k) dst[m][k] = *(const LAS bf16x8*)(lds + PG8_SA(b, h) + aoff + m * 2048 + k * 1024); } while (0)
#define PG8_LDB(dst, b, h) do { _Pragma("unroll") for (int n = 0; n < 2; ++n) _Pragma("unroll") for (int k = 0; k < 2; ++k) dst[n][k] = *(const LAS bf16x8*)(lds + PG8_SB(b, h) + boff + n * 2048 + k * 1024); } while (0)
#define PG8_MMA(ai, bj, At, Bt) do { __builtin_amdgcn_s_setprio(1); _Pragma("unroll") for (int m = 0; m < 4; ++m) _Pragma("unroll") for (int n = 0; n < 2; ++n) _Pragma("unroll") for (int k = 0; k < 2; ++k) \
        acc[ai][bj][m][n] = __builtin_amdgcn_mfma_f32_16x16x32_bf16(Bt[n][k], At[m][k], acc[ai][bj][m][n], 0, 0, 0); __builtin_amdgcn_s_setprio(0); } while (0)
#define PG8_WAIT_V(n) asm volatile("s_waitcnt vmcnt(" #n ")" ::: "memory")
#define PG8_WAIT_L(n) asm volatile("s_waitcnt lgkmcnt(" #n ")" ::: "memory")
#define PG8_BAR __builtin_amdgcn_s_barrier()
#define PG8_SCHED __builtin_amdgcn_sched_barrier(0)
    Unit cur, nxt; int ui = 0;
    if (!S.next(0, cur)) return;
    f32x4 acc[2][2][4][2];
#pragma unroll
    for (int a = 0; a < 2; ++a)
#pragma unroll
        for (int b = 0; b < 2; ++b)
#pragma unroll
            for (int m = 0; m < 4; ++m)
#pragma unroll
                for (int n = 0; n < 2; ++n) acc[a][b][m][n] = (f32x4){0.f, 0.f, 0.f, 0.f};
    bf16x8 At[4][2], B0[2][2], B1[2][2];
    const char* cA = (const char*)g.A + (size_t)cur.pm * tstep; const char* cB = (const char*)g.Bt + (size_t)cur.pn * tstep;
    const int rot = ((((int)blockIdx.x >> 3) & 7) + ((int)blockIdx.x >> 6) + 4 * ((int)blockIdx.x & 7)) & (nt - 1);
#define PG8_KOFF(i) ((size_t)(((i) + rot) & (nt - 1)) * kstep)
    PG8_STAGE(PG8_SB(0, 0), cB + PG8_KOFF(0), voffB); PG8_STAGE(PG8_SA(0, 0), cA + PG8_KOFF(0), voffA); PG8_STAGE(PG8_SB(0, 1), cB + hstep + PG8_KOFF(0), voffB); PG8_STAGE(PG8_SA(0, 1), cA + hstep + PG8_KOFF(0), voffA);
    if (wr == 1) PG8_BAR;
    PG8_WAIT_V(4); PG8_BAR;
    PG8_STAGE(PG8_SB(1, 0), cB + PG8_KOFF(1), voffB); PG8_STAGE(PG8_SA(1, 0), cA + PG8_KOFF(1), voffA); PG8_STAGE(PG8_SB(1, 1), cB + hstep + PG8_KOFF(1), voffB);
    PG8_WAIT_V(6); PG8_BAR;
    for (;;) {
        const bool has_next = S.next(ui + 1, nxt);
        const char* nA = has_next ? (const char*)g.A + (size_t)nxt.pm * tstep : cA; const char* nB = has_next ? (const char*)g.Bt + (size_t)nxt.pn * tstep : cB;
        for (int t = 0; t < nt; t += 2) {
            const bool last = (t == nt - 2);
            const char* a1 = cA + PG8_KOFF(t + 1);
            const size_t o2 = PG8_KOFF(last ? 0 : t + 2), o3 = PG8_KOFF(last ? 1 : t + 3);
            const char* a2 = (last ? nA : cA) + o2; const char* b2 = (last ? nB : cB) + o2;
            const char* a3 = (last ? nA : cA) + o3; const char* b3 = (last ? nB : cB) + o3;
            PG8_LDB(B0, 0, 0); PG8_SCHED; PG8_LDA(At, 0, 0); PG8_STAGE(PG8_SA(1, 1), a1 + hstep, voffA);
            PG8_WAIT_L(8); PG8_BAR; PG8_WAIT_L(0); PG8_MMA(0, 0, At, B0); PG8_BAR; PG8_SCHED;
            PG8_LDB(B1, 0, 1); PG8_STAGE(PG8_SB(0, 0), b2, voffB);
            PG8_BAR; PG8_WAIT_L(0); PG8_MMA(0, 1, At, B1); PG8_BAR;
            PG8_LDA(At, 0, 1); PG8_STAGE(PG8_SA(0, 0), a2, voffA);
            PG8_BAR; PG8_WAIT_L(0); PG8_MMA(1, 0, At, B0); PG8_BAR; PG8_SCHED;
            PG8_STAGE(PG8_SB(0, 1), b2 + hstep, voffB);
            PG8_WAIT_V(6); PG8_BAR; PG8_MMA(1, 1, At, B1); PG8_BAR;
            PG8_LDB(B0, 1, 0); PG8_SCHED; PG8_LDA(At, 1, 0); PG8_STAGE(PG8_SA(0, 1), a2 + hstep, voffA);
            PG8_WAIT_L(8); PG8_BAR; PG8_WAIT_L(0); PG8_MMA(0, 0, At, B0); PG8_BAR; PG8_SCHED;
            PG8_LDB(B1, 1, 1); PG8_STAGE(PG8_SB(1, 0), b3, voffB);
            PG8_BAR; PG8_WAIT_L(0); PG8_MMA(0, 1, At, B1); PG8_BAR;
            PG8_LDA(At, 1, 1); PG8_STAGE(PG8_SA(1, 0), a3, voffA);
            PG8_BAR; PG8_WAIT_L(0); PG8_MMA(1, 0, At, B0); PG8_BAR; PG8_SCHED;
            PG8_STAGE(PG8_SB(1, 1), b3 + hstep, voffB);
            PG8_WAIT_V(6); PG8_BAR; PG8_MMA(1, 1, At, B1); PG8_BAR;
        }
        E(acc, cur, wr, wc, fr, fq);
        if (!has_next) break;
#pragma unroll
        for (int a = 0; a < 2; ++a)
#pragma unroll
            for (int b = 0; b < 2; ++b)
#pragma unroll
                for (int m = 0; m < 4; ++m)
#pragma unroll
                    for (int n = 0; n < 2; ++n) acc[a][b][m][n] = (f32x4){0.f, 0.f, 0.f, 0.f};
        cur = nxt; cA = nA; cB = nB; ++ui;
    }
    PG8_WAIT_V(0);
    if (wr == 0) PG8_BAR;
    PG8_BAR;
#undef PG8_KOFF
#undef PG8_SA
#undef PG8_SB
#undef PG8_STAGE
#undef PG8_LDA
#undef PG8_LDB
#undef PG8_MMA
#undef PG8_WAIT_V
#undef PG8_WAIT_L
#undef PG8_BAR
#undef PG8_SCHED
}
}

__device__ __forceinline__ void pre_work(const Params& p, unsigned char* smem, int ada_lo, int ada_hi, int s0, int c0, int s1, int c1, int s2, int c2, int s3, int c3, int worker, int nworkers) {
    const int tid = otid(), wid = tid >> 6, lane = tid & 63;
    float* fs = (float*)smem;
    float* modp = (float*)(p.ws + WS_MODP);
    for (int it = ada_lo + worker; it < ada_hi; it += nworkers) {
        const int l = it / 192, rem = it % 192, cgi = rem >> 3, kg = rem & 7;
        float* sv = fs; float* red = fs + 1280;
        for (int idx = tid; idx < 1280; idx += 512) {
            const int r = idx >> 8, kk = idx & 255; const int k = kg * 256 + kk;
            const float v = (r == 0) ? p.in[9][k] : p.in[2][(r - 1) * 2048 + k];
            sv[idx] = silu_f(v);
        }
        __syncthreads();
        const float* W = p.in[10] + ((size_t)l * 2048 + kg * 256 + wid * 32) * 6144 + cgi * 256 + lane * 4;
        f32x4 a0 = {0.f, 0.f, 0.f, 0.f}, a1 = a0, a2 = a0, a3 = a0, a4 = a0;
#pragma unroll 16
        for (int kk = 0; kk < 32; ++kk) {
            const f32x4 w4 = __builtin_nontemporal_load((const f32x4*)(W + (size_t)kk * 6144));
            const float* sp = sv + wid * 32 + kk;
            a0 += sp[0] * w4; a1 += sp[256] * w4; a2 += sp[512] * w4; a3 += sp[768] * w4; a4 += sp[1024] * w4;
        }
        *(f32x4*)(red + (wid * 5 + 0) * 256 + lane * 4) = a0;
        *(f32x4*)(red + (wid * 5 + 1) * 256 + lane * 4) = a1;
        *(f32x4*)(red + (wid * 5 + 2) * 256 + lane * 4) = a2;
        *(f32x4*)(red + (wid * 5 + 3) * 256 + lane * 4) = a3;
        *(f32x4*)(red + (wid * 5 + 4) * 256 + lane * 4) = a4;
        __syncthreads();
        for (int idx = tid; idx < 1280; idx += 512) {
            const int r = idx >> 8, n = idx & 255; float s = 0.f;
#pragma unroll
            for (int w = 0; w < 8; ++w) s += red[(w * 5 + r) * 256 + n];
            modp[((size_t)(kg * 4 + l) * 5 + r) * 6144 + cgi * 256 + n] = s;
        }
        __syncthreads();
    }
    {
        const int total = c0 + c1 + c2 + c3;
        f32x4 pre[8];
#define PRE_DECODE(VV, SRC, DST, N, KT, NT) do { int t_ = (VV); \
            if (t_ < c0) t_ += s0; else { t_ -= c0; if (t_ < c1) t_ += s1; else { t_ -= c1; if (t_ < c2) t_ += s2; else t_ += s3 - c2; } } \
            if (t_ < 1664) { N = 6656; const int i_ = t_ / 832; t_ -= i_ * 832; SRC = p.in[14] + (size_t)i_ * 2048 * 6656; DST = (bf16_t*)(p.ws + WS_WIE) + (size_t)i_ * 6656 * LDK; } \
            else if (t_ < 2176) { t_ -= 1664; N = 2048; const int i_ = t_ / 256; t_ -= i_ * 256; SRC = p.in[15] + (size_t)i_ * 2048 * 2048; DST = (bf16_t*)(p.ws + WS_WOE) + (size_t)i_ * 2048 * LDK; } \
            else if (t_ < 4224) { t_ -= 2176; N = 8192; const int i_ = t_ / 1024; t_ -= i_ * 1024; SRC = p.in[18] + (size_t)i_ * 2048 * 8192; DST = (bf16_t*)(p.ws + WS_WIO) + (size_t)i_ * 8192 * LDK; } \
            else { t_ -= 4224; N = 2048; const int i_ = t_ / 256; t_ -= i_ * 256; SRC = p.in[19] + (size_t)i_ * 2048 * 2048; DST = (bf16_t*)(p.ws + WS_WOO) + (size_t)i_ * 2048 * LDK; } \
            const int nN_ = N >> 8; KT = t_ / nN_; NT = t_ - KT * nN_; } while (0)
#define PRE_LOAD(VV) do { const float* src_; bf16_t* dst_; int N_, kt_, nt_; PRE_DECODE(VV, src_, dst_, N_, kt_, nt_); (void)dst_; \
            _Pragma("unroll") for (int j = 0; j < 8; ++j) { const int q = tid + 512 * j; const int kk = q >> 6, n4 = q & 63; \
                pre[j] = __builtin_nontemporal_load((const f32x4*)(src_ + (size_t)(kt_ * 64 + kk) * N_ + nt_ * 256 + n4 * 4)); } } while (0)
        int vv = worker;
        if (vv < total) PRE_LOAD(vv);
        for (; vv < total; vv += nworkers) {
            const float* src; bf16_t* dst; int N, kt, nt; PRE_DECODE(vv, src, dst, N, kt, nt); (void)src;
#pragma unroll
            for (int j = 0; j < 8; ++j) { const int q = tid + 512 * j; const int kk = q >> 6, n4 = q & 63; float* tp = fs + kk * 257 + n4 * 4; tp[0] = pre[j][0]; tp[1] = pre[j][1]; tp[2] = pre[j][2]; tp[3] = pre[j][3]; }
            __syncthreads();
            if (vv + nworkers < total) PRE_LOAD(vv + nworkers);
#pragma unroll
            for (int j = 0; j < 4; ++j) {
                const int c = tid + 512 * j; const int kc = c & 7, nn = c >> 3; const float* tp = fs + (kc * 8) * 257 + nn;
                u32x4 w = {cvt_pk_bf16(tp[0], tp[257]), cvt_pk_bf16(tp[514], tp[771]), cvt_pk_bf16(tp[1028], tp[1285]), cvt_pk_bf16(tp[1542], tp[1799])};
                *(u32x4*)(dst + (size_t)(nt * 256 + nn) * LDK + kt * 64 + kc * 8) = w;
            }
            __syncthreads();
        }
#undef PRE_LOAD
#undef PRE_DECODE
    }
}

__device__ __forceinline__ void mod_reduce(const Params& p, int l_lo, int l_hi, bool with_rope) {
    const int gt = blockIdx.x * 512 + otid(), gs = gridDim.x * 512;
    const float* modp = (const float*)(p.ws + WS_MODP); float* mod = (float*)(p.ws + WS_MOD);
    for (int idx = l_lo * 30720 + gt; idx < l_hi * 30720; idx += gs) {
        const int l = idx / 30720, n = idx % 6144; float s = p.in[11][l * 6144 + n];
#pragma unroll
        for (int kg = 0; kg < 8; ++kg) s += modp[(size_t)kg * 122880 + idx];
        mod[idx] = s;
    }
    if (with_rope) {
        float* rope = (float*)(p.ws + WS_ROPE);
        for (int idx = gt; idx < 2048; idx += gs) {
            const int pos = idx >> 5, d = idx & 31;
            const float inv = exp2f(-(float)d * 0.41524101186092029f);
            const float ang = (float)pos * inv;
            const float n2 = rintf(ang * 0.15915494309189535f);
            float r = fmaf(-n2, 6.2831854820251465f, ang); r = fmaf(-n2, -1.7484555314695172e-07f, r);
            rope[idx * 2] = cosf(r); rope[idx * 2 + 1] = sinf(r);
        }
    }
}

__device__ __forceinline__ void phase_rows(const Params& p, int l, unsigned char* smem) {
    const int tid = otid(); const int wid = tid >> 6, lane = tid & 63;
    const float* mod = (const float*)(p.ws + WS_MOD);
    const bf16_t* OUTB = (const bf16_t*)(p.ws + WS_OUT);
    bf16_t* H = (bf16_t*)(p.ws + WS_H);
    bf16_t* XB = (bf16_t*)(p.ws + WS_XB);
    LAS float* vg = (LAS float*)smem;
    LAS float* va = vg + 2048;
    LAS float* vs = va + 2048;
    for (int base = blockIdx.x * 32; base < NTOK; base += gridDim.x * 32) {
        const int r = base < NPT ? 0 : 1 + ((base - NPT) >> 10);
        __syncthreads();
        {
            const int c4 = tid * 4;
            if (l >= 1) { const f32x4 g4 = *(const f32x4*)(mod + ((l - 1) * 5 + r) * 6144 + 4096 + c4), n4 = *(const f32x4*)(p.in[13] + (l - 1) * 2048 + c4); *(LAS f32x4*)(vg + c4) = g4 * n4; }
            if (l <= 3) {
                f32x4 s4, h4; const f32x4 n4 = *(const f32x4*)(p.in[12] + l * 2048 + c4);
                if (l == 0) {
                    const float* modp = (const float*)(p.ws + WS_MODP);
                    h4 = *(const f32x4*)(p.in[11] + c4); s4 = *(const f32x4*)(p.in[11] + 2048 + c4);
#pragma unroll
                    for (int kg = 0; kg < 8; ++kg) { h4 += *(const f32x4*)(modp + (size_t)kg * 122880 + r * 6144 + c4); s4 += *(const f32x4*)(modp + (size_t)kg * 122880 + r * 6144 + 2048 + c4); }
                } else { s4 = *(const f32x4*)(mod + (l * 5 + r) * 6144 + 2048 + c4); h4 = *(const f32x4*)(mod + (l * 5 + r) * 6144 + c4); }
                *(LAS f32x4*)(va + c4) = n4 * (1.f + s4); *(LAS f32x4*)(vs + c4) = h4; }
        }
        __syncthreads();
#pragma unroll 1
        for (int k4 = 0; k4 < 4; ++k4) {
            const int row = base + wid + 8 * k4;
            f32x4 x[8];
            if (l <= 1) {
                const float* xs = row < NPT ? p.in[0] + (size_t)row * DM : p.in[1] + (size_t)(row - NPT) * DM;
#pragma unroll
                for (int k = 0; k < 8; ++k) x[k] = *(const f32x4*)(xs + (k * 64 + lane) * 4);
            } else {
                const bf16_t* xs = XB + (size_t)row * LDK;
#pragma unroll
                for (int k = 0; k < 8; ++k) { const u32x2 xw = __builtin_nontemporal_load((const u32x2*)(xs + (k * 64 + lane) * 4));
                    x[k] = (f32x4){__uint_as_float(xw[0] << 16), __uint_as_float(xw[0] & 0xffff0000u), __uint_as_float(xw[1] << 16), __uint_as_float(xw[1] & 0xffff0000u)}; }
            }
            if (l >= 1) {
                const bf16_t* os = OUTB + (size_t)row * LDK; f32x4 o[8]; float ss = 0.f;
#pragma unroll
                for (int k = 0; k < 8; ++k) { const u32x2 ow = __builtin_nontemporal_load((const u32x2*)(os + (k * 64 + lane) * 4));
                    o[k] = (f32x4){__uint_as_float(ow[0] << 16), __uint_as_float(ow[0] & 0xffff0000u), __uint_as_float(ow[1] << 16), __uint_as_float(ow[1] & 0xffff0000u)};
                    ss += o[k][0] * o[k][0] + o[k][1] * o[k][1] + o[k][2] * o[k][2] + o[k][3] * o[k][3]; }
                ss = wave_sum(ss); const float rstd = rsqrtf(ss * (1.f / 2048.f) + EPSV);
#pragma unroll
                for (int k = 0; k < 8; ++k) { const int col = (k * 64 + lane) * 4; const f32x4 g4 = *(const LAS f32x4*)(vg + col);
                    x[k] += g4 * (o[k] * rstd);
                    if (l == 4) *(f32x4*)(p.out + (size_t)row * DM + col) = x[k];
                    else { u32x2 w = {cvt_pk_bf16(x[k][0], x[k][1]), cvt_pk_bf16(x[k][2], x[k][3])}; __builtin_nontemporal_store(w, (u32x2*)(XB + (size_t)row * LDK + col));
                        x[k] = (f32x4){__uint_as_float(w[0] << 16), __uint_as_float(w[0] & 0xffff0000u), __uint_as_float(w[1] << 16), __uint_as_float(w[1] & 0xffff0000u)}; } }
            }
            if (l <= 3) {
                float ss = 0.f;
#pragma unroll
                for (int k = 0; k < 8; ++k) ss += x[k][0] * x[k][0] + x[k][1] * x[k][1] + x[k][2] * x[k][2] + x[k][3] * x[k][3];
                ss = wave_sum(ss); const float rstd = rsqrtf(ss * (1.f / 2048.f) + EPSV);
#pragma unroll
                for (int k = 0; k < 8; ++k) { const int col = (k * 64 + lane) * 4; const f32x4 a4 = *(const LAS f32x4*)(va + col), h4 = *(const LAS f32x4*)(vs + col);
                    const f32x4 hv = (x[k] * rstd) * a4 + h4; u32x2 w = {cvt_pk_bf16(hv[0], hv[1]), cvt_pk_bf16(hv[2], hv[3])};
                    *(u32x2*)(H + (size_t)row * LDK + col) = w; }
            }
        }
    }
}

__device__ __forceinline__ void phase_attn(const Params& p, int li, unsigned char* smem, int kmask) {
    const int tid = otid(), wid = __builtin_amdgcn_readfirstlane(tid >> 6), lane = tid & 63, fr = lane & 15, fq = lane >> 4, q4 = fr >> 2, p4 = fr & 3;
    const bf16_t* PROJ = (const bf16_t*)(p.ws + WS_PROJ);
    bf16_t* MIX = (bf16_t*)(p.ws + WS_MIX);
    LAS unsigned char* L0 = (LAS unsigned char*)smem;
    LAS float* rpbl = (LAS float*)(L0 + 73728);
    LAS float* ropel = (LAS float*)(L0 + 75776);
    {
        const float* rope = (const float*)(p.ws + WS_ROPE);
        for (int idx = tid; idx < 4096; idx += 512) ropel[idx] = rope[idx];
    }
    __syncthreads();
    const float SC = 0.08838834764831845f * LOG2E;
    const int kk = tid >> 3, pp = tid & 7, ca = ((pp >> 2) << 3) + (pp & 3), cb = ca + 4;
    for (int u = blockIdx.x; u < 1024; u += gridDim.x) {
        const int kind = u >> 8, uu = u & 255;
        if (!((kmask >> kind) & 1)) continue;
        int b, h, j, rowbase, qcol0, kcol0, vcol0, ocol0; bool has_sink;
        const float* ck = nullptr; const float* cv = nullptr;
        {
            const int xx = uu & 7, yy = uu >> 3;
            if (kind == 0) { const int g = xx * 4 + (yy >> 3); b = g >> 1; h = (g & 1) * 4 + ((yy & 7) >> 1); j = yy & 1; rowbase = b * 256; }
            else if (kind == 1) { const int g = xx * 16 + (yy >> 1); b = g >> 3; h = g & 7; j = yy & 1; rowbase = b * 256; }
            else if (kind == 2) { b = xx >> 1; h = (xx & 1) * 4 + (yy >> 3); j = yy & 7; rowbase = NPT + b * 1024; }
            else { const int g = xx * 4 + (yy >> 3); b = g >> 3; h = g & 7; j = yy & 7; rowbase = NPT + b * 1024; }
        }
        const int mm = j >> 1, half = j & 1;
        if (kind == 0 || kind == 2) { const int kvh = h >> 2; qcol0 = h * 128; kcol0 = 1024 + kvh * 128; vcol0 = 1280 + kvh * 128; ocol0 = h * 128; has_sink = true;
            if (kind == 2) { const size_t co = (size_t)(((b * 2 + li) * 2 + kvh) * 256) * 128; ck = p.in[3] + co; cv = p.in[4] + co; } }
        else { qcol0 = 1536 + h * 128; kcol0 = 2560 + h * 128; vcol0 = 3584 + h * 128; ocol0 = 1024 + h * 128; has_sink = false;
            if (kind == 3) { const size_t co = (size_t)(((b * 2 + li) * 8 + h) * 256) * 128; ck = p.in[5] + co; cv = p.in[6] + co; } }
        const int qi = wid * 16 + fr;
        int qt, qr = 0, qc = 0;
        if (kind == 3) { qr = half * 8 + (qi >> 4); qc = mm * 16 + (qi & 15); qt = qr * 64 + qc; } else qt = j * 128 + qi;
        const size_t qrow = (size_t)(rowbase + qt);
        int cs = mm * 16 - 8; cs = cs < 0 ? 0 : (cs > 32 ? 32 : cs);
        const int kr0 = half ? 4 : 0;
        int r0 = qr - 4; r0 = r0 < 0 ? 0 : (r0 > 8 ? 8 : r0);
        int c0 = qc - 8; c0 = c0 < 0 ? 0 : (c0 > 48 ? 48 : c0);
        int tlo = 4, thi = 4;
        if (kind == 2) { tlo = (j == 0) ? 6 : 4; thi = (j == 7) ? 8 : 10; } else if (kind == 3) { thi = 10; }
        const int cnt = 4 + (thi - tlo);
        f32x4 pre[8];
#define ATT_LOAD(SQ) do { const int t_ = (SQ) < 4 ? (SQ) : tlo + (SQ) - 4; \
            if (kind >= 2 && t_ < 4) { const float* kp_ = ck + (size_t)(t_ * 64 + kk) * 128; const float* vp_ = cv + (size_t)(t_ * 64 + kk) * 128; \
                pre[0] = *(const f32x4*)(kp_ + ca * 8); pre[1] = *(const f32x4*)(kp_ + ca * 8 + 4); pre[2] = *(const f32x4*)(kp_ + cb * 8); pre[3] = *(const f32x4*)(kp_ + cb * 8 + 4); \
                pre[4] = *(const f32x4*)(vp_ + ca * 8); pre[5] = *(const f32x4*)(vp_ + ca * 8 + 4); pre[6] = *(const f32x4*)(vp_ + cb * 8); pre[7] = *(const f32x4*)(vp_ + cb * 8 + 4); \
            } else { int ktok_; \
                if (kind == 3) { const int krow_ = kr0 + (t_ - 4) * 2 + (kk >> 5), kcol_ = cs + (kk & 31); ktok_ = krow_ * 64 + kcol_; } \
                else if (kind == 2) ktok_ = (j - 1) * 128 + (t_ - 4) * 64 + kk; else ktok_ = t_ * 64 + kk; \
                const bf16_t* rp_ = PROJ + (size_t)(rowbase + ktok_) * LDPE; \
                pre[0] = *(const f32x4*)(rp_ + kcol0 + ca * 8); pre[1] = *(const f32x4*)(rp_ + kcol0 + cb * 8); pre[2] = *(const f32x4*)(rp_ + vcol0 + ca * 8); pre[3] = *(const f32x4*)(rp_ + vcol0 + cb * 8); } } while (0)
        bf16x8 qf[4];
#pragma unroll
        for (int ks = 0; ks < 4; ++ks) qf[ks] = *(const bf16x8*)(PROJ + qrow * LDPE + qcol0 + ks * 32 + fq * 8);
        ATT_LOAD(0);
        if (kind == 2) {
            const int pr = qt >> 6, pc = qt & 63;
#pragma unroll
            for (int e = 0; e < 8; ++e) {
                const int d = fq * 8 + e;
                const float cr = ropel[(pr * 32 + d) * 2], sr = ropel[(pr * 32 + d) * 2 + 1], cc = ropel[(pc * 32 + d) * 2], sc = ropel[(pc * 32 + d) * 2 + 1];
                const float x1 = bf2f(qf[0][e]), x2 = bf2f(qf[1][e]), y1 = bf2f(qf[2][e]), y2 = bf2f(qf[3][e]);
                qf[0][e] = (short)f2bf(x1 * cr - x2 * sr); qf[1][e] = (short)f2bf(x2 * cr + x1 * sr);
                qf[2][e] = (short)f2bf(y1 * cc - y2 * sc); qf[3][e] = (short)f2bf(y2 * cc + y1 * sc);
            }
        }
        __syncthreads();
        if (kind == 3) for (int idx = tid; idx < 465; idx += 512) rpbl[idx] = p.in[17][(li * 8 + h) * 465 + idx];
        float m_run = has_sink ? p.in[16][li * 8 + h] * LOG2E : -1e30f;
        float l_run = (has_sink && fq == 0) ? 1.f : 0.f;
        f32x4 o[8];
#pragma unroll
        for (int dt = 0; dt < 8; ++dt) o[dt] = (f32x4){0.f, 0.f, 0.f, 0.f};
        for (int sq = 0; sq < cnt; ++sq) {
            const int tile = sq < 4 ? sq : tlo + sq - 4;
            const bool from_cache = (kind >= 2) && (tile < 4);
            const int kt0 = (kind == 2 && !from_cache) ? (j - 1) * 128 + (tile - 4) * 64 : tile * 64;
            LAS unsigned char* Kl = L0 + (sq & 1) * 36864; LAS unsigned char* Vl = Kl + 18432;
            {
                bf16x8 ka, kb, va, vb;
                if (from_cache) {
                    ka = pack8(pre[0], pre[1]); kb = pack8(pre[2], pre[3]); va = pack8(pre[4], pre[5]); vb = pack8(pre[6], pre[7]);
                } else {
                    ka = __builtin_bit_cast(bf16x8, pre[0]); kb = __builtin_bit_cast(bf16x8, pre[1]); va = __builtin_bit_cast(bf16x8, pre[2]); vb = __builtin_bit_cast(bf16x8, pre[3]);
                    if (kind == 2) {
                        const int ktok = kt0 + kk; const int pos = (pp >> 2) ? (ktok & 63) : (ktok >> 6);
#pragma unroll
                        for (int e = 0; e < 8; ++e) {
                            const int d = (pp & 3) * 8 + e; const float c_ = ropel[(pos * 32 + d) * 2], s_ = ropel[(pos * 32 + d) * 2 + 1];
                            const float x1 = bf2f(ka[e]), x2 = bf2f(kb[e]);
                            ka[e] = (short)f2bf(x1 * c_ - x2 * s_); kb[e] = (short)f2bf(x2 * c_ + x1 * s_);
                        }
                    }
                }
                *(LAS bf16x8*)(Kl + kk * 288 + ca * 16) = ka; *(LAS bf16x8*)(Kl + kk * 288 + cb * 16) = kb;
                *(LAS bf16x8*)(Vl + kk * 288 + ca * 16) = va; *(LAS bf16x8*)(Vl + kk * 288 + cb * 16) = vb;
            }
            if (sq + 1 < cnt) ATT_LOAD(sq + 1);
            __syncthreads();
            bool wskip = false;
            if (!from_cache) {
                if (kind == 2) { const int q0 = j * 128 + wid * 16; const int dist = kt0 > q0 + 15 ? kt0 - (q0 + 15) : (kt0 + 63 < q0 ? q0 - (kt0 + 63) : 0); wskip = dist > 128; }
                else if (kind == 3) { int r0w = half * 8 + wid - 4; r0w = r0w < 0 ? 0 : (r0w > 8 ? 8 : r0w); const int kra = kr0 + (tile - 4) * 2; wskip = (kra + 1 < r0w) || (kra >= r0w + 8); }
            }
            if (!wskip) {
            f32x4 s[4];
#pragma unroll
            for (int kt = 0; kt < 4; ++kt) s[kt] = (f32x4){0.f, 0.f, 0.f, 0.f};
            bf16x8 vfb[2][4];
#define ATT_LDV(B_, BI_) do { _Pragma("unroll") for (int d4 = 0; d4 < 4; ++d4) vfb[B_][d4] = tr2(Vl + ((2 * ((BI_) >> 1)) * 16 + 4 * fq + q4) * 288 + (((BI_) & 1) * 4 + d4) * 32 + 8 * p4, \
                Vl + ((2 * ((BI_) >> 1) + 1) * 16 + 4 * fq + q4) * 288 + (((BI_) & 1) * 4 + d4) * 32 + 8 * p4); } while (0)
            {
                bf16x8 kfb[2][4];
#define ATT_LDK(B_, KS_) do { _Pragma("unroll") for (int kt = 0; kt < 4; ++kt) kfb[B_][kt] = *(const LAS bf16x8*)(Kl + (kt * 16 + fr) * 288 + ((KS_) * 32 + fq * 8) * 2); } while (0)
                ATT_LDK(0, 0);
#pragma unroll
                for (int ks = 0; ks < 4; ++ks) {
                    if (ks + 1 < 4) ATT_LDK((ks + 1) & 1, ks + 1); else ATT_LDV(0, 0);
                    __builtin_amdgcn_sched_barrier(0);
#pragma unroll
                    for (int kt = 0; kt < 4; ++kt) s[kt] = __builtin_amdgcn_mfma_f32_16x16x32_bf16(kfb[ks & 1][kt], qf[ks], s[kt], 0, 0, 0);
                    __builtin_amdgcn_sched_barrier(0);
                }
#undef ATT_LDK
            }
            float mx = -1e30f;
#pragma unroll
            for (int kt = 0; kt < 4; ++kt)
#pragma unroll
                for (int r = 0; r < 4; ++r) {
                    const int k2 = kt * 16 + fq * 4 + r; float v = s[kt][r] * SC;
                    if (!from_cache) {
                        if (kind == 2) { const int dl = qt - (kt0 + k2); if (dl > 128 || dl < -128) v = -1e30f; }
                        else if (kind == 3) {
                            const int krow = kr0 + (tile - 4) * 2 + (k2 >> 5), kcol = cs + (k2 & 31);
                            const bool ok = (krow >= r0) && (krow < r0 + 8) && (kcol >= c0) && (kcol < c0 + 16);
                            int dr = krow - qr + 7; dr = dr < 0 ? 0 : (dr > 14 ? 14 : dr);
                            int dc = kcol - qc + 15; dc = dc < 0 ? 0 : (dc > 30 ? 30 : dc);
                            const float bias = rpbl[dr * 31 + dc];
                            v = ok ? v + bias * LOG2E : -1e30f;
                        }
                    }
                    s[kt][r] = v; mx = fmaxf(mx, v);
                }
            mx = fmaxf(mx, __shfl_xor(mx, 16)); mx = fmaxf(mx, __shfl_xor(mx, 32));
            if (__builtin_amdgcn_ballot_w64(mx - m_run > 8.f) != 0ull) {
                const float m_new = fmaxf(m_run, mx); const float alpha = ex2(m_run - m_new); m_run = m_new;
                l_run *= alpha;
#pragma unroll
                for (int dt = 0; dt < 8; ++dt) o[dt] *= alpha;
            }
            float ps = 0.f;
#pragma unroll
            for (int kt = 0; kt < 4; ++kt)
#pragma unroll
                for (int r = 0; r < 4; ++r) { const float pv = ex2(s[kt][r] - m_run); s[kt][r] = pv; ps += pv; }
            l_run += ps;
            {
                bf16x8 pb[2];
                pb[0] = pack8(s[0], s[1]); pb[1] = pack8(s[2], s[3]);
#pragma unroll
                for (int bi = 0; bi < 4; ++bi) {
                    if (bi + 1 < 4) ATT_LDV((bi + 1) & 1, bi + 1);
                    __builtin_amdgcn_sched_barrier(0);
#pragma unroll
                    for (int d4 = 0; d4 < 4; ++d4) o[(bi & 1) * 4 + d4] = __builtin_amdgcn_mfma_f32_16x16x32_bf16(vfb[bi & 1][d4], pb[bi >> 1], o[(bi & 1) * 4 + d4], 0, 0, 0);
                    __builtin_amdgcn_sched_barrier(0);
                }
            }
            }
#undef ATT_LDV
        }
#undef ATT_LOAD
        float lt = l_run; lt += __shfl_xor(lt, 16); lt += __shfl_xor(lt, 32); const float inv = 1.f / lt;
#pragma unroll
        for (int dt = 0; dt < 8; ++dt) {
            const int d = dt * 16 + fq * 4;
            const u32x2 gg = *(const u32x2*)(PROJ + qrow * LDPE + 4608 + ocol0 + d);
            const float g0 = __uint_as_float(gg[0] << 16), g1 = __uint_as_float(gg[0] & 0xffff0000u), g2 = __uint_as_float(gg[1] << 16), g3 = __uint_as_float(gg[1] & 0xffff0000u);
            u32x2 w = {cvt_pk_bf16(o[dt][0] * inv * silu_f(g0), o[dt][1] * inv * silu_f(g1)), cvt_pk_bf16(o[dt][2] * inv * silu_f(g2), o[dt][3] * inv * silu_f(g3))};
            *(u32x2*)(MIX + qrow * LDK + ocol0 + d) = w;
        }
    }
}

__device__ __forceinline__ int rho(int x) { return (x & ~31) | ((x & 4) << 2) | ((x & 24) >> 1) | (x & 3); }
__device__ __forceinline__ void phase_ret(const Params& p, int li, unsigned char* smem, int kmask) {
    const int tid = otid(), wid = __builtin_amdgcn_readfirstlane(tid >> 6), lane = tid & 63, fr = lane & 15, fq = lane >> 4, q4 = fr >> 2, p4 = fr & 3;
    const bf16_t* PROJ = (const bf16_t*)(p.ws + WS_PROJ);
    LAS unsigned char* Kl = (LAS unsigned char*)smem;
    LAS unsigned char* Vl = Kl + 69632;
    LAS unsigned char* VPl = Vl + 20480;
    LAS unsigned char* Sl = VPl + 20480;
    for (int u = blockIdx.x; u < 1280; u += gridDim.x) {
        const bool sample = u < 256;
        if (!((kmask >> (sample ? 0 : 1)) & 1)) continue;
        const int grp = u >> 8, blk = u & 255, xx = blk & 7, yy = blk >> 3;
        const int es = yy & 3, chain = (sample ? 0 : (grp - 1) * 64) + (yy >> 2) * 8 + xx;
        const int dir = chain & 1, h = (chain >> 1) & 7, b = chain >> 4;
        const int nc = sample ? 8 : 2; const int rowbase = sample ? NPT + b * 1024 : b * 256;
        const float l2g = -__expf((dir ? p.in[21] : p.in[20])[li * 8 + h]) * LOG2E;
        const int ttile = wid < 4 ? wid : 11 - wid;
        const int qi = ttile * 16 + fr;
        bf16x8 kpre[8], vpre[2], qf[8];
#define RET_LOAD(CS) do { const int cx_ = dir ? nc - 1 - (CS) : (CS); const int t0_ = rowbase + cx_ * 128; \
            _Pragma("unroll") for (int it = 0; it < 8; ++it) { const int c = tid + 512 * it; const int jr = c >> 5, c16 = c & 31; const int row = t0_ + (dir ? 127 - jr : jr); \
                kpre[it] = *(const bf16x8*)(PROJ + (size_t)row * LDPO + 2048 + h * 256 + c16 * 8); } \
            _Pragma("unroll") for (int it = 0; it < 2; ++it) { const int c = tid + 512 * it; const int jr = c >> 3, c8 = c & 7; const int row = t0_ + (dir ? 127 - jr : jr); \
                vpre[it] = *(const bf16x8*)(PROJ + (size_t)row * LDPO + 4096 + h * 256 + es * 64 + c8 * 8); } \
            } while (0)
#define RET_LOADQ(CS) do { const int cx_ = dir ? nc - 1 - (CS) : (CS); const size_t qr_ = (size_t)(rowbase + cx_ * 128 + (dir ? 127 - qi : qi)); \
            _Pragma("unroll") for (int ks = 0; ks < 8; ++ks) qf[ks] = *(const bf16x8*)(PROJ + qr_ * LDPO + h * 256 + ks * 32 + fq * 8); } while (0)
        RET_LOAD(0); RET_LOADQ(0);
        f32x4 st[2][4];
        if (sample) {
            const float* s0 = (dir ? p.in[8] : p.in[7]) + (size_t)((b * 2 + li) * 8 + h) * 65536;
#pragma unroll
            for (int a = 0; a < 2; ++a)
#pragma unroll
                for (int et = 0; et < 4; ++et) st[a][et] = *(const f32x4*)(s0 + ((2 * wid + a) * 16 + fr) * 256 + es * 64 + et * 16 + fq * 4);
        } else {
#pragma unroll
            for (int a = 0; a < 2; ++a)
#pragma unroll
                for (int et = 0; et < 4; ++et) st[a][et] = (f32x4){0.f, 0.f, 0.f, 0.f};
        }
        const float cdec = ex2(l2g * 128.f);
        bf16_t* OD = (bf16_t*)(p.ws + (dir ? WS_OB : WS_OF));
        for (int cstep = 0; cstep < nc; ++cstep) {
            const int cidx = dir ? nc - 1 - cstep : cstep;
            const int tok0 = rowbase + cidx * 128;
#pragma unroll
            for (int a = 0; a < 2; ++a)
#pragma unroll
                for (int et = 0; et < 4; ++et) { u32x2 w = {cvt_pk_bf16(st[a][et][0], st[a][et][1]), cvt_pk_bf16(st[a][et][2], st[a][et][3])};
                    *(LAS u32x2*)(Sl + rho((2 * wid + a) * 16 + fr) * 160 + (et * 16 + fq * 4) * 2) = w; }
#pragma unroll
            for (int it = 0; it < 8; ++it) { const int c = tid + 512 * it; const int jr = c >> 5, c16 = c & 31; *(LAS bf16x8*)(Kl + rho(jr) * 544 + c16 * 16) = kpre[it]; }
#pragma unroll
            for (int it = 0; it < 2; ++it) {
                const int c = tid + 512 * it; const int jr = c >> 3, c8 = c & 7; const bf16x8 v = vpre[it];
                *(LAS bf16x8*)(Vl + jr * 160 + c8 * 16) = v;
                const float kd = ex2(l2g * (float)(127 - jr)) * 0.0625f;
                u32x4 w = {cvt_pk_bf16(bf2f(v[0]) * kd, bf2f(v[1]) * kd), cvt_pk_bf16(bf2f(v[2]) * kd, bf2f(v[3]) * kd), cvt_pk_bf16(bf2f(v[4]) * kd, bf2f(v[5]) * kd), cvt_pk_bf16(bf2f(v[6]) * kd, bf2f(v[7]) * kd)};
                *(LAS u32x4*)(VPl + rho(jr) * 160 + c8 * 16) = w;
            }
            const size_t qrow = (size_t)(tok0 + (dir ? 127 - qi : qi));
            __syncthreads();
            if (cstep + 1 < nc) RET_LOAD(cstep + 1);
            f32x4 oc[4];
#pragma unroll
            for (int et = 0; et < 4; ++et) oc[et] = (f32x4){0.f, 0.f, 0.f, 0.f};
            if (sample || cstep > 0)
#pragma unroll
            for (int ks = 0; ks < 8; ++ks) {
                bf16x8 sf[4];
#pragma unroll
                for (int et = 0; et < 4; ++et) sf[et] = tr2(Sl + (ks * 32 + 4 * fq + q4) * 160 + et * 32 + 8 * p4, Sl + (ks * 32 + 16 + 4 * fq + q4) * 160 + et * 32 + 8 * p4);
                __builtin_amdgcn_sched_barrier(0);
#pragma unroll
                for (int et = 0; et < 4; ++et) oc[et] = __builtin_amdgcn_mfma_f32_16x16x32_bf16(sf[et], qf[ks], oc[et], 0, 0, 0);
                __builtin_amdgcn_sched_barrier(0);
            }
            const float qd = ex2(l2g * (float)(qi + 1));
#pragma unroll
            for (int et = 0; et < 4; ++et) oc[et] *= qd;
            for (int jp = 0; jp <= (ttile >> 1); ++jp) {
                f32x4 pt[2];
                pt[0] = (f32x4){0.f, 0.f, 0.f, 0.f}; pt[1] = pt[0];
                const int krow0 = rho((2 * jp) * 16 + fr), krow1 = rho((2 * jp + 1) * 16 + fr);
                if (2 * jp + 1 <= ttile) {
#pragma unroll
                for (int kb = 0; kb < 4; ++kb) {
                    bf16x8 kfr[4];
#pragma unroll
                    for (int kk = 0; kk < 2; ++kk) {
                        kfr[kk * 2 + 0] = *(const LAS bf16x8*)(Kl + krow0 * 544 + ((kb * 2 + kk) * 32 + fq * 8) * 2);
                        kfr[kk * 2 + 1] = *(const LAS bf16x8*)(Kl + krow1 * 544 + ((kb * 2 + kk) * 32 + fq * 8) * 2);
                    }
                    __builtin_amdgcn_sched_barrier(0);
#pragma unroll
                    for (int kk = 0; kk < 2; ++kk) {
                        pt[0] = __builtin_amdgcn_mfma_f32_16x16x32_bf16(kfr[kk * 2 + 0], qf[kb * 2 + kk], pt[0], 0, 0, 0);
                        pt[1] = __builtin_amdgcn_mfma_f32_16x16x32_bf16(kfr[kk * 2 + 1], qf[kb * 2 + kk], pt[1], 0, 0, 0);
                    }
                    __builtin_amdgcn_sched_barrier(0);
                }
                } else {
#pragma unroll
                for (int kb = 0; kb < 2; ++kb) {
                    bf16x8 kfr[4];
#pragma unroll
                    for (int kk = 0; kk < 4; ++kk) kfr[kk] = *(const LAS bf16x8*)(Kl + krow0 * 544 + ((kb * 4 + kk) * 32 + fq * 8) * 2);
                    __builtin_amdgcn_sched_barrier(0);
#pragma unroll
                    for (int kk = 0; kk < 4; ++kk) pt[0] = __builtin_amdgcn_mfma_f32_16x16x32_bf16(kfr[kk], qf[kb * 4 + kk], pt[0], 0, 0, 0);
                    __builtin_amdgcn_sched_barrier(0);
                }
                }
                bf16x8 vfr[4];
#pragma unroll
                for (int et = 0; et < 4; ++et) vfr[et] = tr2(Vl + ((2 * jp) * 16 + 4 * fq + q4) * 160 + et * 32 + 8 * p4, Vl + ((2 * jp + 1) * 16 + 4 * fq + q4) * 160 + et * 32 + 8 * p4);
                __builtin_amdgcn_sched_barrier(0);
#pragma unroll
                for (int t2 = 0; t2 < 2; ++t2)
#pragma unroll
                    for (int r = 0; r < 4; ++r) { const int dl = qi - ((2 * jp + t2) * 16 + fq * 4 + r); pt[t2][r] = dl >= 0 ? pt[t2][r] * ex2(l2g * (float)dl) * 0.0625f : 0.f; }
                const bf16x8 pb = pack8(pt[0], pt[1]);
#pragma unroll
                for (int et = 0; et < 4; ++et) oc[et] = __builtin_amdgcn_mfma_f32_16x16x32_bf16(vfr[et], pb, oc[et], 0, 0, 0);
            }
#pragma unroll
            for (int et = 0; et < 4; ++et) { u32x2 w = {cvt_pk_bf16(oc[et][0], oc[et][1]), cvt_pk_bf16(oc[et][2], oc[et][3])}; *(u32x2*)(OD + qrow * LDK + h * 256 + es * 64 + et * 16 + fq * 4) = w; }
            if (cstep + 1 < nc) RET_LOADQ(cstep + 1);
            if (!sample || cstep + 1 < nc) {
#pragma unroll
            for (int a = 0; a < 2; ++a)
#pragma unroll
                for (int et = 0; et < 4; ++et) st[a][et] *= cdec;
#pragma unroll
            for (int kj = 0; kj < 4; ++kj) {
                bf16x8 uf[6];
#pragma unroll
                for (int et = 0; et < 4; ++et) uf[et] = tr2(VPl + (kj * 32 + 4 * fq + q4) * 160 + et * 32 + 8 * p4, VPl + (kj * 32 + 16 + 4 * fq + q4) * 160 + et * 32 + 8 * p4);
#pragma unroll
                for (int a = 0; a < 2; ++a) uf[4 + a] = tr2(Kl + (kj * 32 + 4 * fq + q4) * 544 + (2 * wid + a) * 32 + 8 * p4, Kl + (kj * 32 + 16 + 4 * fq + q4) * 544 + (2 * wid + a) * 32 + 8 * p4);
                __builtin_amdgcn_sched_barrier(0);
#pragma unroll
                for (int a = 0; a < 2; ++a)
#pragma unroll
                    for (int et = 0; et < 4; ++et) st[a][et] = __builtin_amdgcn_mfma_f32_16x16x32_bf16(uf[et], uf[4 + a], st[a][et], 0, 0, 0);
                __builtin_amdgcn_sched_barrier(0);
            }
            }
            __syncthreads();
        }
#undef RET_LOAD
#undef RET_LOADQ
        if (!sample) {
            float* so = p.out + (dir ? O_RB : O_RF) + (size_t)((b * 2 + li) * 8 + h) * 65536;
#pragma unroll
            for (int a = 0; a < 2; ++a)
#pragma unroll
                for (int et = 0; et < 4; ++et) *(f32x4*)(so + ((2 * wid + a) * 16 + fr) * 256 + es * 64 + et * 16 + fq * 4) = st[a][et];
        }
    }
}

__device__ __forceinline__ void phase_post(const Params& p, int li, unsigned char* smem) {
    const int tid = otid(); const int wid = tid >> 6, lane = tid & 63;
    LAS float* gnl = (LAS float*)smem;
    __syncthreads();
    *(LAS f32x4*)(gnl + tid * 4) = *(const f32x4*)(p.in[22] + li * 2048 + tid * 4);
    __syncthreads();
    const bf16_t* PROJ = (const bf16_t*)(p.ws + WS_PROJ);
    bf16_t* MIX = (bf16_t*)(p.ws + WS_MIX);
    const bf16_t* OF = (const bf16_t*)(p.ws + WS_OF); const bf16_t* OB = (const bf16_t*)(p.ws + WS_OB);
    for (int row = blockIdx.x * 8 + wid; row < NTOK; row += gridDim.x * 8) {
        u32x2 fa[8], fb[8], gg[8];
#pragma unroll
        for (int h = 0; h < 8; ++h) { const size_t off = (size_t)row * LDK + h * 256 + lane * 4;
            fa[h] = __builtin_nontemporal_load((const u32x2*)(OF + off)); fb[h] = __builtin_nontemporal_load((const u32x2*)(OB + off)); gg[h] = __builtin_nontemporal_load((const u32x2*)(PROJ + (size_t)row * LDPO + 6144 + h * 256 + lane * 4)); }
        f32x4 o[8]; float sm[8];
#pragma unroll
        for (int h = 0; h < 8; ++h) {
            o[h] = (f32x4){__uint_as_float(fa[h][0] << 16) + __uint_as_float(fb[h][0] << 16), __uint_as_float(fa[h][0] & 0xffff0000u) + __uint_as_float(fb[h][0] & 0xffff0000u),
                           __uint_as_float(fa[h][1] << 16) + __uint_as_float(fb[h][1] << 16), __uint_as_float(fa[h][1] & 0xffff0000u) + __uint_as_float(fb[h][1] & 0xffff0000u)};
            sm[h] = o[h][0] + o[h][1] + o[h][2] + o[h][3];
        }
#pragma unroll
        for (int sft = 32; sft; sft >>= 1) {
#pragma unroll
            for (int h = 0; h < 8; ++h) sm[h] += __shfl_xor(sm[h], sft);
        }
#pragma unroll
        for (int h = 0; h < 8; ++h) { o[h] -= sm[h] * (1.f / 256.f); sm[h] = o[h][0] * o[h][0] + o[h][1] * o[h][1] + o[h][2] * o[h][2] + o[h][3] * o[h][3]; }
#pragma unroll
        for (int sft = 32; sft; sft >>= 1) {
#pragma unroll
            for (int h = 0; h < 8; ++h) sm[h] += __shfl_xor(sm[h], sft);
        }
#pragma unroll
        for (int h = 0; h < 8; ++h) {
            const float rstd = rsqrtf(sm[h] * (1.f / 256.f) + EPSV);
            const f32x4 g4 = *(const LAS f32x4*)(gnl + h * 256 + lane * 4);
            const float g0 = __uint_as_float(gg[h][0] << 16), g1 = __uint_as_float(gg[h][0] & 0xffff0000u), g2 = __uint_as_float(gg[h][1] << 16), g3 = __uint_as_float(gg[h][1] & 0xffff0000u);
            u32x2 w = {cvt_pk_bf16(o[h][0] * rstd * g4[0] * silu_f(g0), o[h][1] * rstd * g4[1] * silu_f(g1)), cvt_pk_bf16(o[h][2] * rstd * g4[2] * silu_f(g2), o[h][3] * rstd * g4[3] * silu_f(g3))};
            *(u32x2*)(MIX + (size_t)row * LDK + h * 256 + lane * 4) = w;
        }
    }
}

__global__ __launch_bounds__(512) void mega(Params p) {
    __shared__ __attribute__((aligned(16))) unsigned char smem[LDS_BYTES];
    __shared__ uint4 xb_words;
    cg::grid_group grid = cg::this_grid();
    if (threadIdx.x == 0) xb_words = make_uint4(0u, 0u, 0u, 0u);
    __syncthreads();
    XcdBarrier xb; xb.bar = (unsigned*)(p.ws + WS_BAR); xb.x = 0; xb.st = (volatile LAS unsigned*)&xb_words;
    if (p.ph_hi - p.ph_lo > 1) xb = xcd_barrier_post((unsigned*)(p.ws + WS_BAR), (volatile LAS unsigned*)&xb_words);
    bool first = true; int nsync = 0;
#ifndef DUPMASK
#define DUPMASK 0
#endif
#ifndef DUPKIND
#define DUPKIND 15
#endif
    for (int ph2 = p.ph_lo * 2; ph2 < p.ph_hi * 2; ++ph2) {
        const int ph = ph2 >> 1;
        int type, l = 0;
        if (ph == 0) type = 0; else if (ph == 1) type = 1; else if (ph == 22) { type = 2; l = 4; }
        else { l = (ph - 2) / 5; type = 2 + (ph - 2) % 5; }
        if ((type == 5 && !(l & 1)) || type == 1) continue;
        if (ph2 & 1) {
            int bit = type; if (type == 4 && !(l & 1)) bit = 7;
            if (!((DUPMASK >> bit) & 1) || (type == 2 && l >= 2)) continue;
        }
        if (!first) { if (p.ph_lo < 0) grid.sync(); else xcd_barrier(xb); ++nsync; }
        first = false;
        const int li = l >> 1;
        bool do_pre = false; int pa0 = 0, pa1 = 0, ps0 = 0, pc0 = 0, ps1 = 0, pc1 = 0, ps2 = 0, pc2 = 0, ps3 = 0, pc3 = 0, pworker = (int)blockIdx.x, pnw = (int)gridDim.x;
        if (type == 0) { do_pre = true; pa0 = 0; pa1 = 192; ps0 = 0; pc0 = 832; mod_reduce(p, 0, 0, true); }
        else if (type == 2) phase_rows(p, l, smem);
        else if (type == 3) {
            pg8::Gemm g; g.A = (const bf16_t*)(p.ws + WS_H); g.M = NTOK; g.K = DM; g.ld = LDK; pg8::Epi E; E.out = p.out; E.li = li; E.C = (void*)(p.ws + WS_PROJ);
            if (l & 1) { g.Bt = (const bf16_t*)(p.ws + WS_WIO) + (size_t)li * OIN * LDK; g.N = OIN; E.mode = 0; E.ldc = LDPO; }
            else { g.Bt = (const bf16_t*)(p.ws + WS_WIE) + (size_t)li * EIN * LDK; g.N = EIN; E.mode = 1; E.ldc = LDPE; }
            pg8::StaticOrder S; S.init(g.M, g.N, gridDim.x, blockIdx.x);
            pg8::gemm_phase((LAS unsigned char*)smem, g, S, E);
            if (l == 0 || l == 2) {
                const int nfull = 832 % (int)gridDim.x;
                if ((int)blockIdx.x >= nfull) {
                    do_pre = true; pworker = (int)blockIdx.x - nfull; pnw = (int)gridDim.x - nfull;
                    if (l == 0) { pa0 = 192; pa1 = 576; ps0 = 832; pc0 = 832; ps1 = 1664; pc1 = 256; ps2 = 2176; pc2 = 1024; ps3 = 4224; pc3 = 256; }
                    else { pa0 = 576; pa1 = 768; ps0 = 1920; pc0 = 256; ps1 = 3200; pc1 = 1024; ps2 = 4480; pc2 = 256; }
                }
            }
        } else if (type == 4) {
            if (l == 0) mod_reduce(p, 0, 3, false); else if (l == 2) mod_reduce(p, 3, 4, false);
            if (__builtin_amdgcn_readfirstlane((int)threadIdx.x >> 6) >= 4) __builtin_amdgcn_s_setprio(1);
            { const int km = (ph2 & 1) ? DUPKIND : 15; if (l & 1) phase_ret(p, li, smem, km); else phase_attn(p, li, smem, km); }
            __builtin_amdgcn_s_setprio(0);
        } else if (type == 5) phase_post(p, li, smem);
        else {
            pg8::Gemm g; g.A = (const bf16_t*)(p.ws + WS_MIX); g.M = NTOK; g.K = DM; g.ld = LDK; g.N = DM;
            g.Bt = (const bf16_t*)(p.ws + ((l & 1) ? WS_WOO : WS_WOE)) + (size_t)li * DM * LDK;
            pg8::Epi E; E.out = p.out; E.li = li; E.C = (void*)(p.ws + WS_OUT); E.mode = 0; E.ldc = LDK;
            pg8::StaticOrder S; S.init(g.M, g.N, gridDim.x, blockIdx.x);
            pg8::gemm_phase((LAS unsigned char*)smem, g, S, E);
        }
        if (do_pre) pre_work(p, smem, pa0, pa1, ps0, pc0, ps1, pc1, ps2, pc2, ps3, pc3, pworker, pnw);
    }
}

extern "C" void kernel_launch(void* const* d_in, const int* in_sizes, int n_in, void* d_out, int out_size, void* d_ws, size_t ws_size, hipStream_t stream) {
    if (n_in != 23 || ws_size < WS_END) { fprintf(stderr, "kernel_launch: unexpected n_in %d or ws_size %zu (< %zu)\n", n_in, ws_size, (size_t)WS_END); return; }
    Params p{};
    for (int i = 0; i < 23; ++i) p.in[i] = (const float*)d_in[i];
    p.out = (float*)d_out; p.ws = (unsigned char*)d_ws;
    if (hipMemsetAsync((unsigned char*)d_ws + WS_BAR, 0, 3456 * 4, stream) != hipSuccess) { fprintf(stderr, "kernel_launch: memset of the barrier words failed\n"); return; }
#if MULTI_LAUNCH
    for (int ph = 0; ph < NPHASE; ++ph) {
        if (ph >= 2 && ph < 22 && ((ph - 2) % 5) == 3 && (((ph - 2) / 5) & 1) == 0) continue;
        p.ph_lo = ph; p.ph_hi = ph + 1;
        hipLaunchKernelGGL(mega, dim3(256), dim3(512), 0, stream, p);
    }
#else
    static int grid = 0;
    if (!grid) {
        int dev = 0, cus = 0, per_cu = 0;
        (void)hipGetDevice(&dev);
        (void)hipDeviceGetAttribute(&cus, hipDeviceAttributeMultiprocessorCount, dev);
        (void)hipOccupancyMaxActiveBlocksPerMultiprocessor(&per_cu, mega, 512, 0);
        if (per_cu < 1) per_cu = 1;
        if (cus < 1) cus = 256;
        grid = cus * per_cu;
    }
    p.ph_lo = 0; p.ph_hi = NPHASE;
    void* args[] = {&p};
    hipError_t e = hipLaunchCooperativeKernel((void*)mega, dim3(grid), dim3(512), args, 0, stream);
    if (e != hipSuccess) fprintf(stderr, "cooperative launch failed: %s (grid %d)\n", hipGetErrorString(e), grid);
#endif
}
```

```cpp
#include <hip/hip_runtime.h>
#include <hip/hip_cooperative_groups.h>
#include <cstdio>
#include <cstdint>
namespace cg = cooperative_groups;

#ifndef MULTI_LAUNCH
#define MULTI_LAUNCH 0
#endif

#define LAS __attribute__((address_space(3)))
typedef unsigned short bf16_t;
typedef short bf16x8 __attribute__((ext_vector_type(8)));
typedef short s16x4 __attribute__((ext_vector_type(4)));
typedef float f32x4 __attribute__((ext_vector_type(4)));
typedef unsigned u32x2 __attribute__((ext_vector_type(2)));
typedef unsigned u32x4 __attribute__((ext_vector_type(4)));

constexpr int DM = 2048, NTOK = 8192, NPT = 4096, EIN = 6656, OIN = 8192;
constexpr int LDK = 2112, LDPE = 6720, LDPO = 8256;
constexpr float EPSV = 1e-6f;
constexpr float LOG2E = 1.4426950408889634f;
constexpr size_t O_AK = 16777216, O_AV = 18874368, O_BK = 20971520, O_BV = 29360128, O_RF = 37748736, O_RB = 54525952;
constexpr size_t WS_WIE = 0;
constexpr size_t WS_WOE = WS_WIE + (size_t)2 * EIN * LDK * 2;
constexpr size_t WS_WIO = WS_WOE + (size_t)2 * DM * LDK * 2;
constexpr size_t WS_WOO = WS_WIO + (size_t)2 * OIN * LDK * 2;
constexpr size_t WS_H = WS_WOO + (size_t)2 * DM * LDK * 2;
constexpr size_t WS_PROJ = WS_H + (size_t)NTOK * LDK * 2;
constexpr size_t WS_MIX = WS_PROJ + (size_t)NTOK * LDPO * 2;
constexpr size_t WS_OUT = WS_MIX + (size_t)NTOK * LDK * 2;
constexpr size_t WS_OF = WS_OUT + (size_t)NTOK * LDK * 2;
constexpr size_t WS_OB = WS_OF + (size_t)NTOK * LDK * 2;
constexpr size_t WS_MODP = WS_OB + (size_t)NTOK * LDK * 2;
constexpr size_t WS_MOD = WS_MODP + (size_t)8 * 4 * 5 * 6144 * 4;
constexpr size_t WS_ROPE = WS_MOD + (size_t)4 * 5 * 6144 * 4;
constexpr size_t WS_BAR = WS_ROPE + 64 * 32 * 2 * 4;
constexpr size_t WS_XB = WS_BAR + 3456 * 4;
constexpr size_t WS_END = WS_XB + (size_t)NTOK * LDK * 2;

constexpr int LDS_BYTES = 151552;
constexpr int NPHASE = 23;

struct Params {
    const float* in[23];
    float* out;
    unsigned char* ws;
    int ph_lo, ph_hi;
};

__device__ __forceinline__ unsigned cvt_pk_bf16(float lo, float hi) { unsigned r; asm("v_cvt_pk_bf16_f32 %0, %1, %2" : "=v"(r) : "v"(lo), "v"(hi)); return r; }
__device__ __forceinline__ unsigned short f2bf(float f) { return (unsigned short)(cvt_pk_bf16(f, 0.f) & 0xffffu); }
__device__ __forceinline__ float bf2f(short b) { return __uint_as_float(((unsigned)(unsigned short)b) << 16); }
__device__ __forceinline__ int otid() { int t = threadIdx.x; asm volatile("" : "+v"(t)); return t; }
__device__ __forceinline__ float wave_sum(float v) {
#pragma unroll
    for (int o = 32; o; o >>= 1) v += __shfl_xor(v, o);
    return v;
}
__device__ __forceinline__ float silu_f(float v) { return v / (1.f + __expf(-v)); }
__device__ __forceinline__ float ex2(float v) { return __builtin_amdgcn_exp2f(v); }
__device__ __forceinline__ bf16x8 cvt8(const float* p) {
    f32x4 a = *(const f32x4*)p, b = *(const f32x4*)(p + 4);
    u32x4 w = {cvt_pk_bf16(a[0], a[1]), cvt_pk_bf16(a[2], a[3]), cvt_pk_bf16(b[0], b[1]), cvt_pk_bf16(b[2], b[3])};
    return __builtin_bit_cast(bf16x8, w);
}
__device__ __forceinline__ bf16x8 pack8(f32x4 a, f32x4 b) {
    u32x4 w = {cvt_pk_bf16(a[0], a[1]), cvt_pk_bf16(a[2], a[3]), cvt_pk_bf16(b[0], b[1]), cvt_pk_bf16(b[2], b[3])};
    return __builtin_bit_cast(bf16x8, w);
}
__device__ __forceinline__ bf16x8 tr2(LAS unsigned char* a0, LAS unsigned char* a1) {
    s16x4 x = __builtin_amdgcn_ds_read_tr16_b64_v4i16((LAS s16x4*)a0);
    s16x4 y = __builtin_amdgcn_ds_read_tr16_b64_v4i16((LAS s16x4*)a1);
    bf16x8 r = {x[0], x[1], x[2], x[3], y[0], y[1], y[2], y[3]};
    return r;
}

#define XB_TMO      128
#define XB_XCNT(j)  (256  + 64 * (j))
#define XB_XSUB(j)  (1280 + 64 * (j))
#define XB_XGEN(j)  (2304 + 64 * (j))
#define XB_TOP      3328
#define XB_TOPGEN   3392
#define XCD_BAR_WORDS 3456
#define XB_SPIN_CAP (1u << 18)
__device__ __forceinline__ unsigned xb_ld(unsigned* p)              { return __hip_atomic_load(p, __ATOMIC_RELAXED, __HIP_MEMORY_SCOPE_AGENT); }
__device__ __forceinline__ unsigned xb_add(unsigned* p, unsigned v) { return __hip_atomic_fetch_add(p, v, __ATOMIC_RELAXED, __HIP_MEMORY_SCOPE_AGENT); }
__device__ __forceinline__ unsigned xb_xcc_id() { return (unsigned)__builtin_amdgcn_s_getreg((3 << 11) | 20) & 0xFu; }
#define XB_SPIN(cond, bar) do { unsigned _sp = 0; while (cond) { __builtin_amdgcn_s_sleep(1); \
    if ((++_sp & 255u) == 0u) { if (xb_ld(&(bar)[XB_TMO])) break; if (_sp > XB_SPIN_CAP) { atomicAdd(&(bar)[XB_TMO], 1u); break; } } } } while (0)
struct XcdBarrier { unsigned* bar; unsigned x; volatile LAS unsigned* st; };
__device__ __forceinline__ XcdBarrier xcd_barrier_post(unsigned* bar, volatile LAS unsigned* st) {
    XcdBarrier b; b.bar = bar; b.x = xb_xcc_id(); b.st = st;
    if (threadIdx.x == 0) (void)xb_add(&bar[XB_XCNT(b.x)], 1u);
    return b;
}
__device__ __forceinline__ void xcd_barrier_complete(unsigned* bar, unsigned x, unsigned& nloc, unsigned& nx) {
    const unsigned G = gridDim.x * gridDim.y * gridDim.z;
    unsigned sum, cnt, mine, sp = 0u;
    for (;;) {
        sum = 0u; cnt = 0u; mine = 0u;
#pragma unroll
        for (unsigned j = 0; j < 16; ++j) { const unsigned c = xb_ld(&bar[XB_XCNT(j)]); sum += c; cnt += (c > 0u) ? 1u : 0u; mine = (j == x) ? c : mine; }
        if (sum == G) break;
        __builtin_amdgcn_s_sleep(1);
        if ((++sp & 255u) == 0u) { if (xb_ld(&bar[XB_TMO])) break; if (sp > XB_SPIN_CAP) { atomicAdd(&bar[XB_TMO], 1u); break; } }
    }
    nloc = mine > 0u ? mine : 1u; nx = cnt > 0u ? cnt : 1u;
}
__device__ __forceinline__ void xcd_barrier(const XcdBarrier& b) {
    asm volatile("s_waitcnt vmcnt(0)" ::: "memory");
    __syncthreads();
    if (threadIdx.x == 0) {
        unsigned* bar = b.bar;
        __builtin_amdgcn_s_waitcnt(0);
        unsigned nloc = b.st[0], nx = b.st[1];
        if (nloc == 0u) { xcd_barrier_complete(bar, b.x, nloc, nx); b.st[0] = nloc; b.st[1] = nx; }
        const unsigned old = xb_add(&bar[XB_XSUB(b.x)], 1u);
        const unsigned gen = old / nloc;
        if (old + 1u == (gen + 1u) * nloc) {
            __builtin_amdgcn_fence(__ATOMIC_RELEASE, "agent");
            asm volatile("s_waitcnt vmcnt(0)" ::: "memory");
            const unsigned og = xb_add(&bar[XB_TOP], 1u);
            const unsigned tg = og / nx;
            if (og + 1u == (tg + 1u) * nx) xb_add(&bar[XB_TOPGEN], 1u);
            else XB_SPIN(xb_ld(&bar[XB_TOPGEN]) == tg, bar);
            __builtin_amdgcn_fence(__ATOMIC_ACQUIRE, "agent");
            xb_add(&bar[XB_XGEN(b.x)], 1u);
            asm volatile("s_waitcnt vmcnt(0)" ::: "memory");
        } else {
            XB_SPIN(xb_ld(&bar[XB_XGEN(b.x)]) == gen, bar);
            __builtin_amdgcn_fence(__ATOMIC_ACQUIRE, "agent");
            asm volatile("s_waitcnt vmcnt(0)" ::: "memory");
        }
    }
    __syncthreads();
}

namespace pg8 {
constexpr int BM = 256, BK = 64, HALF = 128, HTB = HALF * BK * 2, STAGE_BYTES = 8 * HTB, NXCD = 8, WGM = 4;
__device__ __forceinline__ int lds_byte(int r, int c) { const int st = (r >> 4) * 2 + (c >> 5), rr = r & 15, cc = c & 31, ob = rr * 64 + cc * 2; return st * 1024 + (ob ^ (((ob >> 9) & 1) << 5)); }
__device__ __forceinline__ void stage_rc(int b, int& R, int& C) { const int st = b / 1024, sb = b % 1024, swz = sb ^ (((sb >> 9) & 1) << 5); R = (st >> 1) * 16 + swz / 64; C = (st & 1) * 32 + (swz % 64) / 2; }
__device__ __forceinline__ int perm32(int rho) { const int n = rho >> 4, i = rho & 15; return 8 * (i >> 2) + 4 * n + (i & 3); }
struct Unit { int pm, pn; };
struct Gemm { const bf16_t* A; const bf16_t* Bt; int M, N, K, ld; };
struct StaticOrder {
    int nM, nN, nwg, G, c;
    __device__ void init(int M, int N, int G_, int c_) { nM = M / BM; nN = N / BM; nwg = nM * nN; G = G_; c = c_; }
    __device__ bool next(int i, Unit& u) const {
        const long L = (long)i * G + c; if (L >= nwg) return false;
        int wgid = (int)L; { const int q = nwg / NXCD, r = nwg % NXCD, xcd = wgid % NXCD, off = wgid / NXCD; wgid = (xcd < r ? xcd * (q + 1) : r * (q + 1) + (xcd - r) * q) + off; }
        const int nig = WGM * nN, gid = wgid / nig, fm = gid * WGM, gsz = (nM - fm) < WGM ? (nM - fm) : WGM;
        u.pm = fm + ((wgid % nig) % gsz); u.pn = (wgid % nig) / gsz; return true;
    }
};

struct Epi {
    int mode;
    void* C; int ldc; float* out; int li;
    __device__ __forceinline__ void operator()(const f32x4 (&acc)[2][2][4][2], const Unit& u, int wr, int wc, int fr, int fq) const {
        const int row0 = u.pm * BM + wr * 64 + fr, col0 = u.pn * BM + wc * 32 + 8 * fq;
#pragma unroll
        for (int ai = 0; ai < 2; ++ai)
#pragma unroll
            for (int m = 0; m < 4; ++m) { bf16_t* rowp = (bf16_t*)C + (size_t)(row0 + ai * HALF + m * 16) * ldc + col0;
#pragma unroll
                for (int bj = 0; bj < 2; ++bj) { const f32x4 v0 = acc[ai][bj][m][0], v1 = acc[ai][bj][m][1];
                    u32x4 w = {cvt_pk_bf16(v0[0], v0[1]), cvt_pk_bf16(v0[2], v0[3]), cvt_pk_bf16(v1[0], v1[1]), cvt_pk_bf16(v1[2], v1[3])}; *(u32x4*)(rowp + bj * HALF) = w; } }
        if (mode == 1 && u.pm < 16) {
            const int pn = u.pn; float* base = nullptr; int c0 = 0, nh = 2;
            if (pn == 4) { base = out + O_AK; c0 = 1024; nh = 2; }
            else if (pn == 5) { base = out + O_AV; c0 = 1280; nh = 2; }
            else if (pn >= 10 && pn < 14) { base = out + O_BK; c0 = 2560; nh = 8; }
            else if (pn >= 14 && pn < 18) { base = out + O_BV; c0 = 3584; nh = 8; }
            if (base) {
                const int b = u.pm;
#pragma unroll
                for (int ai = 0; ai < 2; ++ai)
#pragma unroll
                    for (int m = 0; m < 4; ++m) { const int t = wr * 64 + fr + ai * HALF + m * 16;
#pragma unroll
                        for (int bj = 0; bj < 2; ++bj)
#pragma unroll
                            for (int n = 0; n < 2; ++n) { const int c2 = col0 + bj * HALF + 4 * n - c0; const int hh = c2 >> 7, d = c2 & 127;
                                *(f32x4*)(base + ((size_t)((b * 2 + li) * nh + hh) * 256 + t) * 128 + d) = acc[ai][bj][m][n]; } }
            }
        }
    }
};

__device__ __forceinline__ void gemm_phase(LAS unsigned char* lds, const Gemm g, const StaticOrder& S, const Epi& E) {
    const int tid = otid(), wid = __builtin_amdgcn_readfirstlane(tid >> 6), lane = tid & 63, wr = wid >> 2, wc = wid & 3, fr = lane & 15, fq = lane >> 4;
    const int K = g.ld, nt = g.K / BK;
    unsigned voffA[2], voffB[2];
#pragma unroll
    for (int i = 0; i < 2; ++i) { int R, C; stage_rc(tid * 16 + i * 8192, R, C); const int Rb = (R & ~31) + perm32(R & 31); voffA[i] = (unsigned)(R * K + C) * 2u; voffB[i] = (unsigned)(Rb * K + C) * 2u; }
    const size_t kstep = (size_t)(BK * 2);
    const size_t hstep = (size_t)HALF * K * 2;
    const size_t tstep = 2 * hstep;
    const unsigned ldsw = (unsigned)wid * 1024u;
    const int aoff = lds_byte(wr * 64 + fr, fq * 8), boff = lds_byte(wc * 32 + fr, fq * 8);
#define PG8_SA(b, h) (((b) * 2 + (h)) * HTB)
#define PG8_SB(b, h) ((4 + (b) * 2 + (h)) * HTB)
#define PG8_STAGE(bufoff, gbase, voff) do { _Pragma("unroll") for (int _i = 0; _i < 2; ++_i) \
        __builtin_amdgcn_global_load_lds((const unsigned*)((const char*)(gbase) + (voff)[_i]), (LAS unsigned*)(lds + (bufoff) + ldsw + _i * 8192), 16, 0, 0); } while (0)
#define PG8_LDA(dst, b, h) do { _Pragma("unroll") for (int m = 0; m < 4; ++m) _Pragma("unroll") for (int k = 0; k < 2; ++k) dst[m][k] = *(const LAS bf16x8*)(lds + PG8_SA(b, h) + aoff + m * 2048 + k * 1024); } while (0)
#define PG8_LDB(dst, b, h) do { _Pragma("unroll") for (int n = 0; n < 2; ++n) _Pragma("unroll") for (int k = 0; k < 2; ++k) dst[n][k] = *(const LAS bf16x8*)(lds + PG8_SB(b, h) + boff + n * 2048 + k * 1024); } while (0)
#define PG8_MMA(ai, bj, At, Bt) do { __builtin_amdgcn_s_setprio(1); _Pragma("unroll") for (int m = 0; m < 4; ++m) _Pragma("unroll") for (int n = 0; n < 2; ++n) _Pragma("unroll") for (int k = 0; k < 2; ++k) \
        acc[ai][bj][m][n] = __builtin_amdgcn_mfma_f32_16x16x32_bf16(Bt[n][k], At[m][k], acc[ai][bj][m][n], 0, 0, 0); __builtin_amdgcn_s_setprio(0); } while (0)
#define PG8_WAIT_V(n) asm volatile("s_waitcnt vmcnt(" #n ")" ::: "memory")
#define PG8_WAIT_L(n) asm volatile("s_waitcnt lgkmcnt(" #n ")" ::: "memory")
#define PG8_BAR __builtin_amdgcn_s_barrier()
#define PG8_SCHED __builtin_amdgcn_sched_barrier(0)
    Unit cur, nxt; int ui = 0;
    if (!S.next(0, cur)) return;
    f32x4 acc[2][2][4][2];
#pragma unroll
    for (int a = 0; a < 2; ++a)
#pragma unroll
        for (int b = 0; b < 2; ++b)
#pragma unroll
            for (int m = 0; m < 4; ++m)
#pragma unroll
                for (int n = 0; n < 2; ++n) acc[a][b][m][n] = (f32x4){0.f, 0.f, 0.f, 0.f};
    bf16x8 At[4][2], B0[2][2], B1[2][2];
    const char* cA = (const char*)g.A + (size_t)cur.pm * tstep; const char* cB = (const char*)g.Bt + (size_t)cur.pn * tstep;
    const int rot = ((((int)blockIdx.x >> 3) & 7) + ((int)blockIdx.x >> 6) + 4 * ((int)blockIdx.x & 7)) & (nt - 1);
#define PG8_KOFF(i) ((size_t)(((i) + rot) & (nt - 1)) * kstep)
    PG8_STAGE(PG8_SB(0, 0), cB + PG8_KOFF(0), voffB); PG8_STAGE(PG8_SA(0, 0), cA + PG8_KOFF(0), voffA); PG8_STAGE(PG8_SB(0, 1), cB + hstep + PG8_KOFF(0), voffB); PG8_STAGE(PG8_SA(0, 1), cA + hstep + PG8_KOFF(0), voffA);
    if (wr == 1) PG8_BAR;
    PG8_WAIT_V(4); PG8_BAR;
    PG8_STAGE(PG8_SB(1, 0), cB + PG8_KOFF(1), voffB); PG8_STAGE(PG8_SA(1, 0), cA + PG8_KOFF(1), voffA); PG8_STAGE(PG8_SB(1, 1), cB + hstep + PG8_KOFF(1), voffB);
    PG8_WAIT_V(6); PG8_BAR;
    for (;;) {
        const bool has_next = S.next(ui + 1, nxt);
        const char* nA = has_next ? (const char*)g.A + (size_t)nxt.pm * tstep : cA; const char* nB = has_next ? (const char*)g.Bt + (size_t)nxt.pn * tstep : cB;
        for (int t = 0; t < nt; t += 2) {
            const bool last = (t == nt - 2);
            const char* a1 = cA + PG8_KOFF(t + 1);
            const size_t o2 = PG8_KOFF(last ? 0 : t + 2), o3 = PG8_KOFF(last ? 1 : t + 3);
            const char* a2 = (last ? nA : cA) + o2; const char* b2 = (last ? nB : cB) + o2;
            const char* a3 = (last ? nA : cA) + o3; const char* b3 = (last ? nB : cB) + o3;
            PG8_LDB(B0, 0, 0); PG8_SCHED; PG8_LDA(At, 0, 0); PG8_STAGE(PG8_SA(1, 1), a1 + hstep, voffA);
            PG8_WAIT_L(8); PG8_BAR; PG8_WAIT_L(0); PG8_MMA(0, 0, At, B0); PG8_BAR; PG8_SCHED;
            PG8_LDB(B1, 0, 1); PG8_STAGE(PG8_SB(0, 0), b2, voffB);
            PG8_BAR; PG8_WAIT_L(0); PG8_MMA(0, 1, At, B1); PG8_BAR;
            PG8_LDA(At, 0, 1); PG8_STAGE(PG8_SA(0, 0), a2, voffA);
            PG8_BAR; PG8_WAIT_L(0); PG8_MMA(1, 0, At, B0); PG8_BAR; PG8_SCHED;
            PG8_STAGE(PG8_SB(0, 1), b2 + hstep, voffB);
            PG8_WAIT_V(6); PG8_BAR; PG8_MMA(1, 1, At, B1); PG8_BAR;
            PG8_LDB(B0, 1, 0); PG8_SCHED; PG8_LDA(At, 1, 0); PG8_STAGE(PG8_SA(0, 1), a2 + hstep, voffA);
            PG8_WAIT_L(8); PG8_BAR; PG8_WAIT_L(0); PG8_MMA(0, 0, At, B0); PG8_BAR; PG8_SCHED;
            PG8_LDB(B1, 1, 1); PG8_STAGE(PG8_SB(1, 0), b3, voffB);
            PG8_BAR; PG8_WAIT_L(0); PG8_MMA(0, 1, At, B1); PG8_BAR;
            PG8_LDA(At, 1, 1); PG8_STAGE(PG8_SA(1, 0), a3, voffA);
            PG8_BAR; PG8_WAIT_L(0); PG8_MMA(1, 0, At, B0); PG8_BAR; PG8_SCHED;
            PG8_STAGE(PG8_SB(1, 1), b3 + hstep, voffB);
            PG8_WAIT_V(6); PG8_BAR; PG8_MMA(1, 1, At, B1); PG8_BAR;
        }
        E(acc, cur, wr, wc, fr, fq);
        if (!has_next) break;
#pragma unroll
        for (int a = 0; a < 2; ++a)
#pragma unroll
            for (int b = 0; b < 2; ++b)
#pragma unroll
                for (int m = 0; m < 4; ++m)
#pragma unroll
                    for (int n = 0; n < 2; ++n) acc[a][b][m][n] = (f32x4){0.f, 0.f, 0.f, 0.f};
        cur = nxt; cA = nA; cB = nB; ++ui;
    }
    PG8_WAIT_V(0);
    if (wr == 0) PG8_BAR;
    PG8_BAR;
#undef PG8_KOFF
#undef PG8_SA
#undef PG8_SB
#undef PG8_STAGE
#undef PG8_LDA
#undef PG8_LDB
#undef PG8_MMA
#undef PG8_WAIT_V
#undef PG8_WAIT_L
#undef PG8_BAR
#undef PG8_SCHED
}
}

__device__ __forceinline__ void pre_work(const Params& p, unsigned char* smem, int ada_lo, int ada_hi, int s0, int c0, int s1, int c1, int s2, int c2, int s3, int c3, int worker, int nworkers) {
    const int tid = otid(), wid = tid >> 6, lane = tid & 63;
    float* fs = (float*)smem;
    float* modp = (float*)(p.ws + WS_MODP);
    for (int it = ada_lo + worker; it < ada_hi; it += nworkers) {
        const int l = it / 192, rem = it % 192, cgi = rem >> 3, kg = rem & 7;
        float* sv = fs; float* red = fs + 1280;
        for (int idx = tid; idx < 1280; idx += 512) {
            const int r = idx >> 8, kk = idx & 255; const int k = kg * 256 + kk;
            const float v = (r == 0) ? p.in[9][k] : p.in[2][(r - 1) * 2048 + k];
            sv[idx] = silu_f(v);
        }
        __syncthreads();
        const float* W = p.in[10] + ((size_t)l * 2048 + kg * 256 + wid * 32) * 6144 + cgi * 256 + lane * 4;
        f32x4 a0 = {0.f, 0.f, 0.f, 0.f}, a1 = a0, a2 = a0, a3 = a0, a4 = a0;
#pragma unroll 16
        for (int kk = 0; kk < 32; ++kk) {
            const f32x4 w4 = __builtin_nontemporal_load((const f32x4*)(W + (size_t)kk * 6144));
            const float* sp = sv + wid * 32 + kk;
            a0 += sp[0] * w4; a1 += sp[256] * w4; a2 += sp[512] * w4; a3 += sp[768] * w4; a4 += sp[1024] * w4;
        }
        *(f32x4*)(red + (wid * 5 + 0) * 256 + lane * 4) = a0;
        *(f32x4*)(red + (wid * 5 + 1) * 256 + lane * 4) = a1;
        *(f32x4*)(red + (wid * 5 + 2) * 256 + lane * 4) = a2;
        *(f32x4*)(red + (wid * 5 + 3) * 256 + lane * 4) = a3;
        *(f32x4*)(red + (wid * 5 + 4) * 256 + lane * 4) = a4;
        __syncthreads();
        for (int idx = tid; idx < 1280; idx += 512) {
            const int r = idx >> 8, n = idx & 255; float s = 0.f;
#pragma unroll
            for (int w = 0; w < 8; ++w) s += red[(w * 5 + r) * 256 + n];
            modp[((size_t)(kg * 4 + l) * 5 + r) * 6144 + cgi * 256 + n] = s;
        }
        __syncthreads();
    }
    {
        const int total = c0 + c1 + c2 + c3;
        f32x4 pre[8];
#define PRE_DECODE(VV, SRC, DST, N, KT, NT) do { int t_ = (VV); \
            if (t_ < c0) t_ += s0; else { t_ -= c0; if (t_ < c1) t_ += s1; else { t_ -= c1; if (t_ < c2) t_ += s2; else t_ += s3 - c2; } } \
            if (t_ < 1664) { N = 6656; const int i_ = t_ / 832; t_ -= i_ * 832; SRC = p.in[14] + (size_t)i_ * 2048 * 6656; DST = (bf16_t*)(p.ws + WS_WIE) + (size_t)i_ * 6656 * LDK; } \
            else if (t_ < 2176) { t_ -= 1664; N = 2048; const int i_ = t_ / 256; t_ -= i_ * 256; SRC = p.in[15] + (size_t)i_ * 2048 * 2048; DST = (bf16_t*)(p.ws + WS_WOE) + (size_t)i_ * 2048 * LDK; } \
            else if (t_ < 4224) { t_ -= 2176; N = 8192; const int i_ = t_ / 1024; t_ -= i_ * 1024; SRC = p.in[18] + (size_t)i_ * 2048 * 8192; DST = (bf16_t*)(p.ws + WS_WIO) + (size_t)i_ * 8192 * LDK; } \
            else { t_ -= 4224; N = 2048; const int i_ = t_ / 256; t_ -= i_ * 256; SRC = p.in[19] + (size_t)i_ * 2048 * 2048; DST = (bf16_t*)(p.ws + WS_WOO) + (size_t)i_ * 2048 * LDK; } \
            const int nN_ = N >> 8; KT = t_ / nN_; NT = t_ - KT * nN_; } while (0)
#define PRE_LOAD(VV) do { const float* src_; bf16_t* dst_; int N_, kt_, nt_; PRE_DECODE(VV, src_, dst_, N_, kt_, nt_); (void)dst_; \
            _Pragma("unroll") for (int j = 0; j < 8; ++j) { const int q = tid + 512 * j; const int kk = q >> 6, n4 = q & 63; \
                pre[j] = __builtin_nontemporal_load((const f32x4*)(src_ + (size_t)(kt_ * 64 + kk) * N_ + nt_ * 256 + n4 * 4)); } } while (0)
        int vv = worker;
        if (vv < total) PRE_LOAD(vv);
        for (; vv < total; vv += nworkers) {
            const float* src; bf16_t* dst; int N, kt, nt; PRE_DECODE(vv, src, dst, N, kt, nt); (void)src;
#pragma unroll
            for (int j = 0; j < 8; ++j) { const int q = tid + 512 * j; const int kk = q >> 6, n4 = q & 63; float* tp = fs + kk * 257 + n4 * 4; tp[0] = pre[j][0]; tp[1] = pre[j][1]; tp[2] = pre[j][2]; tp[3] = pre[j][3]; }
            __syncthreads();
            if (vv + nworkers < total) PRE_LOAD(vv + nworkers);
#pragma unroll
            for (int j = 0; j < 4; ++j) {
                const int c = tid + 512 * j; const int kc = c & 7, nn = c >> 3; const float* tp = fs + (kc * 8) * 257 + nn;
                u32x4 w = {cvt_pk_bf16(tp[0], tp[257]), cvt_pk_bf16(tp[514], tp[771]), cvt_pk_bf16(tp[1028], tp[1285]), cvt_pk_bf16(tp[1542], tp[1799])};
                *(u32x4*)(dst + (size_t)(nt * 256 + nn) * LDK + kt * 64 + kc * 8) = w;
            }
            __syncthreads();
        }
#undef PRE_LOAD
#undef PRE_DECODE
    }
}

__device__ __forceinline__ void mod_reduce(const Params& p, int l_lo, int l_hi, bool with_rope) {
    const int gt = blockIdx.x * 512 + otid(), gs = gridDim.x * 512;
    const float* modp = (const float*)(p.ws + WS_MODP); float* mod = (float*)(p.ws + WS_MOD);
    for (int idx = l_lo * 30720 + gt; idx < l_hi * 30720; idx += gs) {
        const int l = idx / 30720, n = idx % 6144; float s = p.in[11][l * 6144 + n];
#pragma unroll
        for (int kg = 0; kg < 8; ++kg) s += modp[(size_t)kg * 122880 + idx];
        mod[idx] = s;
    }
    if (with_rope) {
        float* rope = (float*)(p.ws + WS_ROPE);
        for (int idx = gt; idx < 2048; idx += gs) {
            const int pos = idx >> 5, d = idx & 31;
            const float inv = exp2f(-(float)d * 0.41524101186092029f);
            const float ang = (float)pos * inv;
            const float n2 = rintf(ang * 0.15915494309189535f);
            float r = fmaf(-n2, 6.2831854820251465f, ang); r = fmaf(-n2, -1.7484555314695172e-07f, r);
            rope[idx * 2] = cosf(r); rope[idx * 2 + 1] = sinf(r);
        }
    }
}

__device__ __forceinline__ void phase_rows(const Params& p, int l, unsigned char* smem) {
    const int tid = otid(); const int wid = tid >> 6, lane = tid & 63;
    const float* mod = (const float*)(p.ws + WS_MOD);
    const bf16_t* OUTB = (const bf16_t*)(p.ws + WS_OUT);
    bf16_t* H = (bf16_t*)(p.ws + WS_H);
    bf16_t* XB = (bf16_t*)(p.ws + WS_XB);
    LAS float* vg = (LAS float*)smem;
    LAS float* va = vg + 2048;
    LAS float* vs = va + 2048;
    for (int base = blockIdx.x * 32; base < NTOK; base += gridDim.x * 32) {
        const int r = base < NPT ? 0 : 1 + ((base - NPT) >> 10);
        __syncthreads();
        {
            const int c4 = tid * 4;
            if (l >= 1) { const f32x4 g4 = *(const f32x4*)(mod + ((l - 1) * 5 + r) * 6144 + 4096 + c4), n4 = *(const f32x4*)(p.in[13] + (l - 1) * 2048 + c4); *(LAS f32x4*)(vg + c4) = g4 * n4; }
            if (l <= 3) {
                f32x4 s4, h4; const f32x4 n4 = *(const f32x4*)(p.in[12] + l * 2048 + c4);
                if (l == 0) {
                    const float* modp = (const float*)(p.ws + WS_MODP);
                    h4 = *(const f32x4*)(p.in[11] + c4); s4 = *(const f32x4*)(p.in[11] + 2048 + c4);
#pragma unroll
                    for (int kg = 0; kg < 8; ++kg) { h4 += *(const f32x4*)(modp + (size_t)kg * 122880 + r * 6144 + c4); s4 += *(const f32x4*)(modp + (size_t)kg * 122880 + r * 6144 + 2048 + c4); }
                } else { s4 = *(const f32x4*)(mod + (l * 5 + r) * 6144 + 2048 + c4); h4 = *(const f32x4*)(mod + (l * 5 + r) * 6144 + c4); }
                *(LAS f32x4*)(va + c4) = n4 * (1.f + s4); *(LAS f32x4*)(vs + c4) = h4; }
        }
        __syncthreads();
#pragma unroll 1
        for (int k4 = 0; k4 < 4; ++k4) {
            const int row = base + wid + 8 * k4;
            f32x4 x[8];
            if (l <= 1) {
                const float* xs = row < NPT ? p.in[0] + (size_t)row * DM : p.in[1] + (size_t)(row - NPT) * DM;
#pragma unroll
                for (int k = 0; k < 8; ++k) x[k] = *(const f32x4*)(xs + (k * 64 + lane) * 4);
            } else {
                const bf16_t* xs = XB + (size_t)row * LDK;
#pragma unroll
                for (int k = 0; k < 8; ++k) { const u32x2 xw = __builtin_nontemporal_load((const u32x2*)(xs + (k * 64 + lane) * 4));
                    x[k] = (f32x4){__uint_as_float(xw[0] << 16), __uint_as_float(xw[0] & 0xffff0000u), __uint_as_float(xw[1] << 16), __uint_as_float(xw[1] & 0xffff0000u)}; }
            }
            if (l >= 1) {
                const bf16_t* os = OUTB + (size_t)row * LDK; f32x4 o[8]; float ss = 0.f;
#pragma unroll
                for (int k = 0; k < 8; ++k) { const u32x2 ow = __builtin_nontemporal_load((const u32x2*)(os + (k * 64 + lane) * 4));
                    o[k] = (f32x4){__uint_as_float(ow[0] << 16), __uint_as_float(ow[0] & 0xffff0000u), __uint_as_float(ow[1] << 16), __uint_as_float(ow[1] & 0xffff0000u)};
                    ss += o[k][0] * o[k][0] + o[k][1] * o[k][1] + o[k][2] * o[k][2] + o[k][3] * o[k][3]; }
                ss = wave_sum(ss); const float rstd = rsqrtf(ss * (1.f / 2048.f) + EPSV);
#pragma unroll
                for (int k = 0; k < 8; ++k) { const int col = (k * 64 + lane) * 4; const f32x4 g4 = *(const LAS f32x4*)(vg + col);
                    x[k] += g4 * (o[k] * rstd);
                    if (l == 4) __builtin_nontemporal_store(x[k], (f32x4*)(p.out + (size_t)row * DM + col));
                    else { u32x2 w = {cvt_pk_bf16(x[k][0], x[k][1]), cvt_pk_bf16(x[k][2], x[k][3])}; __builtin_nontemporal_store(w, (u32x2*)(XB + (size_t)row * LDK + col));
                        x[k] = (f32x4){__uint_as_float(w[0] << 16), __uint_as_float(w[0] & 0xffff0000u), __uint_as_float(w[1] << 16), __uint_as_float(w[1] & 0xffff0000u)}; } }
            }
            if (l <= 3) {
                float ss = 0.f;
#pragma unroll
                for (int k = 0; k < 8; ++k) ss += x[k][0] * x[k][0] + x[k][1] * x[k][1] + x[k][2] * x[k][2] + x[k][3] * x[k][3];
                ss = wave_sum(ss); const float rstd = rsqrtf(ss * (1.f / 2048.f) + EPSV);
#pragma unroll
                for (int k = 0; k < 8; ++k) { const int col = (k * 64 + lane) * 4; const f32x4 a4 = *(const LAS f32x4*)(va + col), h4 = *(const LAS f32x4*)(vs + col);
                    const f32x4 hv = (x[k] * rstd) * a4 + h4; u32x2 w = {cvt_pk_bf16(hv[0], hv[1]), cvt_pk_bf16(hv[2], hv[3])};
                    *(u32x2*)(H + (size_t)row * LDK + col) = w; }
            }
        }
    }
}

__device__ __forceinline__ void phase_attn(const Params& p, int li, unsigned char* smem, int kmask) {
    const int tid = otid(), wid = __builtin_amdgcn_readfirstlane(tid >> 6), lane = tid & 63, fr = lane & 15, fq = lane >> 4, q4 = fr >> 2, p4 = fr & 3;
    const bf16_t* PROJ = (const bf16_t*)(p.ws + WS_PROJ);
    bf16_t* MIX = (bf16_t*)(p.ws + WS_MIX);
    LAS unsigned char* L0 = (LAS unsigned char*)smem;
    LAS float* rpbl = (LAS float*)(L0 + 73728);
    LAS float* ropel = (LAS float*)(L0 + 75776);
    {
        const float* rope = (const float*)(p.ws + WS_ROPE);
        for (int idx = tid; idx < 4096; idx += 512) ropel[idx] = rope[idx];
    }
    __syncthreads();
    const float SC = 0.08838834764831845f * LOG2E;
    const int kk = tid >> 3, pp = tid & 7, ca = ((pp >> 2) << 3) + (pp & 3), cb = ca + 4;
    for (int u = blockIdx.x; u < 1024; u += gridDim.x) {
        const int kind = u >> 8, uu = u & 255;
        if (!((kmask >> kind) & 1)) continue;
        int b, h, j, rowbase, qcol0, kcol0, vcol0, ocol0; bool has_sink;
        const float* ck = nullptr; const float* cv = nullptr;
        {
            const int xx = uu & 7, yy = uu >> 3;
            if (kind == 0) { const int g = xx * 4 + (yy >> 3); b = g >> 1; h = (g & 1) * 4 + ((yy & 7) >> 1); j = yy & 1; rowbase = b * 256; }
            else if (kind == 1) { const int g = xx * 16 + (yy >> 1); b = g >> 3; h = g & 7; j = yy & 1; rowbase = b * 256; }
            else if (kind == 2) { b = xx >> 1; h = (xx & 1) * 4 + (yy >> 3); j = yy & 7; rowbase = NPT + b * 1024; }
            else { const int g = xx * 4 + (yy >> 3); b = g >> 3; h = g & 7; j = yy & 7; rowbase = NPT + b * 1024; }
        }
        const int mm = j >> 1, half = j & 1;
        if (kind == 0 || kind == 2) { const int kvh = h >> 2; qcol0 = h * 128; kcol0 = 1024 + kvh * 128; vcol0 = 1280 + kvh * 128; ocol0 = h * 128; has_sink = true;
            if (kind == 2) { const size_t co = (size_t)(((b * 2 + li) * 2 + kvh) * 256) * 128; ck = p.in[3] + co; cv = p.in[4] + co; } }
        else { qcol0 = 1536 + h * 128; kcol0 = 2560 + h * 128; vcol0 = 3584 + h * 128; ocol0 = 1024 + h * 128; has_sink = false;
            if (kind == 3) { const size_t co = (size_t)(((b * 2 + li) * 8 + h) * 256) * 128; ck = p.in[5] + co; cv = p.in[6] + co; } }
        const int qi = wid * 16 + fr;
        int qt, qr = 0, qc = 0;
        if (kind == 3) { qr = half * 8 + (qi >> 4); qc = mm * 16 + (qi & 15); qt = qr * 64 + qc; } else qt = j * 128 + qi;
        const size_t qrow = (size_t)(rowbase + qt);
        int cs = mm * 16 - 8; cs = cs < 0 ? 0 : (cs > 32 ? 32 : cs);
        const int kr0 = half ? 4 : 0;
        int r0 = qr - 4; r0 = r0 < 0 ? 0 : (r0 > 8 ? 8 : r0);
        int c0 = qc - 8; c0 = c0 < 0 ? 0 : (c0 > 48 ? 48 : c0);
        int tlo = 4, thi = 4;
        if (kind == 2) { tlo = (j == 0) ? 6 : 4; thi = (j == 7) ? 8 : 10; } else if (kind == 3) { thi = 10; }
        const int cnt = 4 + (thi - tlo);
        f32x4 pre[8];
#define ATT_LOAD(SQ) do { const int t_ = (SQ) < 4 ? (SQ) : tlo + (SQ) - 4; \
            if (kind >= 2 && t_ < 4) { const float* kp_ = ck + (size_t)(t_ * 64 + kk) * 128; const float* vp_ = cv + (size_t)(t_ * 64 + kk) * 128; \
                pre[0] = *(const f32x4*)(kp_ + ca * 8); pre[1] = *(const f32x4*)(kp_ + ca * 8 + 4); pre[2] = *(const f32x4*)(kp_ + cb * 8); pre[3] = *(const f32x4*)(kp_ + cb * 8 + 4); \
                pre[4] = *(const f32x4*)(vp_ + ca * 8); pre[5] = *(const f32x4*)(vp_ + ca * 8 + 4); pre[6] = *(const f32x4*)(vp_ + cb * 8); pre[7] = *(const f32x4*)(vp_ + cb * 8 + 4); \
            } else { int ktok_; \
                if (kind == 3) { const int krow_ = kr0 + (t_ - 4) * 2 + (kk >> 5), kcol_ = cs + (kk & 31); ktok_ = krow_ * 64 + kcol_; } \
                else if (kind == 2) ktok_ = (j - 1) * 128 + (t_ - 4) * 64 + kk; else ktok_ = t_ * 64 + kk; \
                const bf16_t* rp_ = PROJ + (size_t)(rowbase + ktok_) * LDPE; \
                pre[0] = *(const f32x4*)(rp_ + kcol0 + ca * 8); pre[1] = *(const f32x4*)(rp_ + kcol0 + cb * 8); pre[2] = *(const f32x4*)(rp_ + vcol0 + ca * 8); pre[3] = *(const f32x4*)(rp_ + vcol0 + cb * 8); } } while (0)
        bf16x8 qf[4];
#pragma unroll
        for (int ks = 0; ks < 4; ++ks) qf[ks] = *(const bf16x8*)(PROJ + qrow * LDPE + qcol0 + ks * 32 + fq * 8);
        ATT_LOAD(0);
        if (kind == 2) {
            const int pr = qt >> 6, pc = qt & 63;
#pragma unroll
            for (int e = 0; e < 8; ++e) {
                const int d = fq * 8 + e;
                const float cr = ropel[(pr * 32 + d) * 2], sr = ropel[(pr * 32 + d) * 2 + 1], cc = ropel[(pc * 32 + d) * 2], sc = ropel[(pc * 32 + d) * 2 + 1];
                const float x1 = bf2f(qf[0][e]), x2 = bf2f(qf[1][e]), y1 = bf2f(qf[2][e]), y2 = bf2f(qf[3][e]);
                qf[0][e] = (short)f2bf(x1 * cr - x2 * sr); qf[1][e] = (short)f2bf(x2 * cr + x1 * sr);
                qf[2][e] = (short)f2bf(y1 * cc - y2 * sc); qf[3][e] = (short)f2bf(y2 * cc + y1 * sc);
            }
        }
        __syncthreads();
        if (kind == 3) for (int idx = tid; idx < 465; idx += 512) rpbl[idx] = p.in[17][(li * 8 + h) * 465 + idx];
        float m_run = has_sink ? p.in[16][li * 8 + h] * LOG2E : -1e30f;
        float l_run = (has_sink && fq == 0) ? 1.f : 0.f;
        f32x4 o[8];
#pragma unroll
        for (int dt = 0; dt < 8; ++dt) o[dt] = (f32x4){0.f, 0.f, 0.f, 0.f};
        for (int sq = 0; sq < cnt; ++sq) {
            const int tile = sq < 4 ? sq : tlo + sq - 4;
            const bool from_cache = (kind >= 2) && (tile < 4);
            const int kt0 = (kind == 2 && !from_cache) ? (j - 1) * 128 + (tile - 4) * 64 : tile * 64;
            LAS unsigned char* Kl = L0 + (sq & 1) * 36864; LAS unsigned char* Vl = Kl + 18432;
            {
                bf16x8 ka, kb, va, vb;
                if (from_cache) {
                    ka = pack8(pre[0], pre[1]); kb = pack8(pre[2], pre[3]); va = pack8(pre[4], pre[5]); vb = pack8(pre[6], pre[7]);
                } else {
                    ka = __builtin_bit_cast(bf16x8, pre[0]); kb = __builtin_bit_cast(bf16x8, pre[1]); va = __builtin_bit_cast(bf16x8, pre[2]); vb = __builtin_bit_cast(bf16x8, pre[3]);
                    if (kind == 2) {
                        const int ktok = kt0 + kk; const int pos = (pp >> 2) ? (ktok & 63) : (ktok >> 6);
#pragma unroll
                        for (int e = 0; e < 8; ++e) {
                            const int d = (pp & 3) * 8 + e; const float c_ = ropel[(pos * 32 + d) * 2], s_ = ropel[(pos * 32 + d) * 2 + 1];
                            const float x1 = bf2f(ka[e]), x2 = bf2f(kb[e]);
                            ka[e] = (short)f2bf(x1 * c_ - x2 * s_); kb[e] = (short)f2bf(x2 * c_ + x1 * s_);
                        }
                    }
                }
                *(LAS bf16x8*)(Kl + kk * 288 + ca * 16) = ka; *(LAS bf16x8*)(Kl + kk * 288 + cb * 16) = kb;
                *(LAS bf16x8*)(Vl + kk * 288 + ca * 16) = va; *(LAS bf16x8*)(Vl + kk * 288 + cb * 16) = vb;
            }
            if (sq + 1 < cnt) ATT_LOAD(sq + 1);
            __syncthreads();
            bool wskip = false;
            if (!from_cache) {
                if (kind == 2) { const int q0 = j * 128 + wid * 16; const int dist = kt0 > q0 + 15 ? kt0 - (q0 + 15) : (kt0 + 63 < q0 ? q0 - (kt0 + 63) : 0); wskip = dist > 128; }
                else if (kind == 3) { int r0w = half * 8 + wid - 4; r0w = r0w < 0 ? 0 : (r0w > 8 ? 8 : r0w); const int kra = kr0 + (tile - 4) * 2; wskip = (kra + 1 < r0w) || (kra >= r0w + 8); }
            }
            if (!wskip) {
            f32x4 s[4];
#pragma unroll
            for (int kt = 0; kt < 4; ++kt) s[kt] = (f32x4){0.f, 0.f, 0.f, 0.f};
            bf16x8 vfb[2][4];
#define ATT_LDV(B_, BI_) do { _Pragma("unroll") for (int d4 = 0; d4 < 4; ++d4) vfb[B_][d4] = tr2(Vl + ((2 * ((BI_) >> 1)) * 16 + 4 * fq + q4) * 288 + (((BI_) & 1) * 4 + d4) * 32 + 8 * p4, \
                Vl + ((2 * ((BI_) >> 1) + 1) * 16 + 4 * fq + q4) * 288 + (((BI_) & 1) * 4 + d4) * 32 + 8 * p4); } while (0)
            {
                bf16x8 kfb[2][4];
#define ATT_LDK(B_, KS_) do { _Pragma("unroll") for (int kt = 0; kt < 4; ++kt) kfb[B_][kt] = *(const LAS bf16x8*)(Kl + (kt * 16 + fr) * 288 + ((KS_) * 32 + fq * 8) * 2); } while (0)
                ATT_LDK(0, 0);
#pragma unroll
                for (int ks = 0; ks < 4; ++ks) {
                    if (ks + 1 < 4) ATT_LDK((ks + 1) & 1, ks + 1); else ATT_LDV(0, 0);
                    __builtin_amdgcn_sched_barrier(0);
#pragma unroll
                    for (int kt = 0; kt < 4; ++kt) s[kt] = __builtin_amdgcn_mfma_f32_16x16x32_bf16(kfb[ks & 1][kt], qf[ks], s[kt], 0, 0, 0);
                    __builtin_amdgcn_sched_barrier(0);
                }
#undef ATT_LDK
            }
            float mx = -1e30f;
#pragma unroll
            for (int kt = 0; kt < 4; ++kt)
#pragma unroll
                for (int r = 0; r < 4; ++r) {
                    const int k2 = kt * 16 + fq * 4 + r; float v = s[kt][r] * SC;
                    if (!from_cache) {
                        if (kind == 2) { const int dl = qt - (kt0 + k2); if (dl > 128 || dl < -128) v = -1e30f; }
                        else if (kind == 3) {
                            const int krow = kr0 + (tile - 4) * 2 + (k2 >> 5), kcol = cs + (k2 & 31);
                            const bool ok = (krow >= r0) && (krow < r0 + 8) && (kcol >= c0) && (kcol < c0 + 16);
                            int dr = krow - qr + 7; dr = dr < 0 ? 0 : (dr > 14 ? 14 : dr);
                            int dc = kcol - qc + 15; dc = dc < 0 ? 0 : (dc > 30 ? 30 : dc);
                            const float bias = rpbl[dr * 31 + dc];
                            v = ok ? v + bias * LOG2E : -1e30f;
                        }
                    }
                    s[kt][r] = v; mx = fmaxf(mx, v);
                }
            mx = fmaxf(mx, __shfl_xor(mx, 16)); mx = fmaxf(mx, __shfl_xor(mx, 32));
            if (__builtin_amdgcn_ballot_w64(mx - m_run > 8.f) != 0ull) {
                const float m_new = fmaxf(m_run, mx); const float alpha = ex2(m_run - m_new); m_run = m_new;
                l_run *= alpha;
#pragma unroll
                for (int dt = 0; dt < 8; ++dt) o[dt] *= alpha;
            }
            float ps = 0.f;
#pragma unroll
            for (int kt = 0; kt < 4; ++kt)
#pragma unroll
                for (int r = 0; r < 4; ++r) { const float pv = ex2(s[kt][r] - m_run); s[kt][r] = pv; ps += pv; }
            l_run += ps;
            {
                bf16x8 pb[2];
                pb[0] = pack8(s[0], s[1]); pb[1] = pack8(s[2], s[3]);
#pragma unroll
                for (int bi = 0; bi < 4; ++bi) {
                    if (bi + 1 < 4) ATT_LDV((bi + 1) & 1, bi + 1);
                    __builtin_amdgcn_sched_barrier(0);
#pragma unroll
                    for (int d4 = 0; d4 < 4; ++d4) o[(bi & 1) * 4 + d4] = __builtin_amdgcn_mfma_f32_16x16x32_bf16(vfb[bi & 1][d4], pb[bi >> 1], o[(bi & 1) * 4 + d4], 0, 0, 0);
                    __builtin_amdgcn_sched_barrier(0);
                }
            }
            }
#undef ATT_LDV
        }
#undef ATT_LOAD
        float lt = l_run; lt += __shfl_xor(lt, 16); lt += __shfl_xor(lt, 32); const float inv = 1.f / lt;
#pragma unroll
        for (int dt = 0; dt < 8; ++dt) {
            const int d = dt * 16 + fq * 4;
            const u32x2 gg = *(const u32x2*)(PROJ + qrow * LDPE + 4608 + ocol0 + d);
            const float g0 = __uint_as_float(gg[0] << 16), g1 = __uint_as_float(gg[0] & 0xffff0000u), g2 = __uint_as_float(gg[1] << 16), g3 = __uint_as_float(gg[1] & 0xffff0000u);
            u32x2 w = {cvt_pk_bf16(o[dt][0] * inv * silu_f(g0), o[dt][1] * inv * silu_f(g1)), cvt_pk_bf16(o[dt][2] * inv * silu_f(g2), o[dt][3] * inv * silu_f(g3))};
            *(u32x2*)(MIX + qrow * LDK + ocol0 + d) = w;
        }
    }
}

__device__ __forceinline__ int rho(int x) { return (x & ~31) | ((x & 4) << 2) | ((x & 24) >> 1) | (x & 3); }
__device__ __forceinline__ void phase_ret(const Params& p, int li, unsigned char* smem, int kmask) {
    const int tid = otid(), wid = __builtin_amdgcn_readfirstlane(tid >> 6), lane = tid & 63, fr = lane & 15, fq = lane >> 4, q4 = fr >> 2, p4 = fr & 3;
    const bf16_t* PROJ = (const bf16_t*)(p.ws + WS_PROJ);
    LAS unsigned char* Kl = (LAS unsigned char*)smem;
    LAS unsigned char* Vl = Kl + 69632;
    LAS unsigned char* VPl = Vl + 20480;
    LAS unsigned char* Sl = VPl + 20480;
    for (int u = blockIdx.x; u < 1280; u += gridDim.x) {
        const bool sample = u < 256;
        if (!((kmask >> (sample ? 0 : 1)) & 1)) continue;
        const int grp = u >> 8, blk = u & 255, xx = blk & 7, yy = blk >> 3;
        const int es = yy & 3, chain = (sample ? 0 : (grp - 1) * 64) + (yy >> 2) * 8 + xx;
        const int dir = chain & 1, h = (chain >> 1) & 7, b = chain >> 4;
        const int nc = sample ? 8 : 2; const int rowbase = sample ? NPT + b * 1024 : b * 256;
        const float l2g = -__expf((dir ? p.in[21] : p.in[20])[li * 8 + h]) * LOG2E;
        const int ttile = wid < 4 ? wid : 11 - wid;
        const int qi = ttile * 16 + fr;
        bf16x8 kpre[8], vpre[2], qf[8];
#define RET_LOAD(CS) do { const int cx_ = dir ? nc - 1 - (CS) : (CS); const int t0_ = rowbase + cx_ * 128; \
            _Pragma("unroll") for (int it = 0; it < 8; ++it) { const int c = tid + 512 * it; const int jr = c >> 5, c16 = c & 31; const int row = t0_ + (dir ? 127 - jr : jr); \
                kpre[it] = *(const bf16x8*)(PROJ + (size_t)row * LDPO + 2048 + h * 256 + c16 * 8); } \
            _Pragma("unroll") for (int it = 0; it < 2; ++it) { const int c = tid + 512 * it; const int jr = c >> 3, c8 = c & 7; const int row = t0_ + (dir ? 127 - jr : jr); \
                vpre[it] = *(const bf16x8*)(PROJ + (size_t)row * LDPO + 4096 + h * 256 + es * 64 + c8 * 8); } \
            } while (0)
#define RET_LOADQ(CS) do { const int cx_ = dir ? nc - 1 - (CS) : (CS); const size_t qr_ = (size_t)(rowbase + cx_ * 128 + (dir ? 127 - qi : qi)); \
            _Pragma("unroll") for (int ks = 0; ks < 8; ++ks) qf[ks] = *(const bf16x8*)(PROJ + qr_ * LDPO + h * 256 + ks * 32 + fq * 8); } while (0)
        RET_LOAD(0); RET_LOADQ(0);
        f32x4 st[2][4];
        if (sample) {
            const float* s0 = (dir ? p.in[8] : p.in[7]) + (size_t)((b * 2 + li) * 8 + h) * 65536;
#pragma unroll
            for (int a = 0; a < 2; ++a)
#pragma unroll
                for (int et = 0; et < 4; ++et) st[a][et] = *(const f32x4*)(s0 + ((2 * wid + a) * 16 + fr) * 256 + es * 64 + et * 16 + fq * 4);
        } else {
#pragma unroll
            for (int a = 0; a < 2; ++a)
#pragma unroll
                for (int et = 0; et < 4; ++et) st[a][et] = (f32x4){0.f, 0.f, 0.f, 0.f};
        }
        const float cdec = ex2(l2g * 128.f);
        bf16_t* OD = (bf16_t*)(p.ws + (dir ? WS_OB : WS_OF));
        for (int cstep = 0; cstep < nc; ++cstep) {
            const int cidx = dir ? nc - 1 - cstep : cstep;
            const int tok0 = rowbase + cidx * 128;
#pragma unroll
            for (int a = 0; a < 2; ++a)
#pragma unroll
                for (int et = 0; et < 4; ++et) { u32x2 w = {cvt_pk_bf16(st[a][et][0], st[a][et][1]), cvt_pk_bf16(st[a][et][2], st[a][et][3])};
                    *(LAS u32x2*)(Sl + rho((2 * wid + a) * 16 + fr) * 160 + (et * 16 + fq * 4) * 2) = w; }
#pragma unroll
            for (int it = 0; it < 8; ++it) { const int c = tid + 512 * it; const int jr = c >> 5, c16 = c & 31; *(LAS bf16x8*)(Kl + rho(jr) * 544 + c16 * 16) = kpre[it]; }
#pragma unroll
            for (int it = 0; it < 2; ++it) {
                const int c = tid + 512 * it; const int jr = c >> 3, c8 = c & 7; const bf16x8 v = vpre[it];
                *(LAS bf16x8*)(Vl + jr * 160 + c8 * 16) = v;
                const float kd = ex2(l2g * (float)(127 - jr)) * 0.0625f;
                u32x4 w = {cvt_pk_bf16(bf2f(v[0]) * kd, bf2f(v[1]) * kd), cvt_pk_bf16(bf2f(v[2]) * kd, bf2f(v[3]) * kd), cvt_pk_bf16(bf2f(v[4]) * kd, bf2f(v[5]) * kd), cvt_pk_bf16(bf2f(v[6]) * kd, bf2f(v[7]) * kd)};
                *(LAS u32x4*)(VPl + rho(jr) * 160 + c8 * 16) = w;
            }
            const size_t qrow = (size_t)(tok0 + (dir ? 127 - qi : qi));
            __syncthreads();
            if (cstep + 1 < nc) RET_LOAD(cstep + 1);
            f32x4 oc[4];
#pragma unroll
            for (int et = 0; et < 4; ++et) oc[et] = (f32x4){0.f, 0.f, 0.f, 0.f};
            if (sample || cstep > 0)
#pragma unroll
            for (int ks = 0; ks < 8; ++ks) {
                bf16x8 sf[4];
#pragma unroll
                for (int et = 0; et < 4; ++et) sf[et] = tr2(Sl + (ks * 32 + 4 * fq + q4) * 160 + et * 32 + 8 * p4, Sl + (ks * 32 + 16 + 4 * fq + q4) * 160 + et * 32 + 8 * p4);
                __builtin_amdgcn_sched_barrier(0);
#pragma unroll
                for (int et = 0; et < 4; ++et) oc[et] = __builtin_amdgcn_mfma_f32_16x16x32_bf16(sf[et], qf[ks], oc[et], 0, 0, 0);
                __builtin_amdgcn_sched_barrier(0);
            }
            const float qd = ex2(l2g * (float)(qi + 1));
#pragma unroll
            for (int et = 0; et < 4; ++et) oc[et] *= qd;
            for (int jp = 0; jp <= (ttile >> 1); ++jp) {
                f32x4 pt[2];
                pt[0] = (f32x4){0.f, 0.f, 0.f, 0.f}; pt[1] = pt[0];
                const int krow0 = rho((2 * jp) * 16 + fr), krow1 = rho((2 * jp + 1) * 16 + fr);
                if (2 * jp + 1 <= ttile) {
#pragma unroll
                for (int kb = 0; kb < 4; ++kb) {
                    bf16x8 kfr[4];
#pragma unroll
                    for (int kk = 0; kk < 2; ++kk) {
                        kfr[kk * 2 + 0] = *(const LAS bf16x8*)(Kl + krow0 * 544 + ((kb * 2 + kk) * 32 + fq * 8) * 2);
                        kfr[kk * 2 + 1] = *(const LAS bf16x8*)(Kl + krow1 * 544 + ((kb * 2 + kk) * 32 + fq * 8) * 2);
                    }
                    __builtin_amdgcn_sched_barrier(0);
#pragma unroll
                    for (int kk = 0; kk < 2; ++kk) {
                        pt[0] = __builtin_amdgcn_mfma_f32_16x16x32_bf16(kfr[kk * 2 + 0], qf[kb * 2 + kk], pt[0], 0, 0, 0);
                        pt[1] = __builtin_amdgcn_mfma_f32_16x16x32_bf16(kfr[kk * 2 + 1], qf[kb * 2 + kk], pt[1], 0, 0, 0);
                    }
                    __builtin_amdgcn_sched_barrier(0);
                }
                } else {
#pragma unroll
                for (int kb = 0; kb < 2; ++kb) {
                    bf16x8 kfr[4];
#pragma unroll
                    for (int kk = 0; kk < 4; ++kk) kfr[kk] = *(const LAS bf16x8*)(Kl + krow0 * 544 + ((kb * 4 + kk) * 32 + fq * 8) * 2);
                    __builtin_amdgcn_sched_barrier(0);
#pragma unroll
                    for (int kk = 0; kk < 4; ++kk) pt[0] = __builtin_amdgcn_mfma_f32_16x16x32_bf16(kfr[kk], qf[kb * 4 + kk], pt[0], 0, 0, 0);
                    __builtin_amdgcn_sched_barrier(0);
                }
                }
                bf16x8 vfr[4];
#pragma unroll
                for (int et = 0; et < 4; ++et) vfr[et] = tr2(Vl + ((2 * jp) * 16 + 4 * fq + q4) * 160 + et * 32 + 8 * p4, Vl + ((2 * jp + 1) * 16 + 4 * fq + q4) * 160 + et * 32 + 8 * p4);
                __builtin_amdgcn_sched_barrier(0);
#pragma unroll
                for (int t2 = 0; t2 < 2; ++t2)
#pragma unroll
                    for (int r = 0; r < 4; ++r) { const int dl = qi - ((2 * jp + t2) * 16 + fq * 4 + r); pt[t2][r] = dl >= 0 ? pt[t2][r] * ex2(l2g * (float)dl) * 0.0625f : 0.f; }
                const bf16x8 pb = pack8(pt[0], pt[1]);
#pragma unroll
                for (int et = 0; et < 4; ++et) oc[et] = __builtin_amdgcn_mfma_f32_16x16x32_bf16(vfr[et], pb, oc[et], 0, 0, 0);
            }
#pragma unroll
            for (int et = 0; et < 4; ++et) { u32x2 w = {cvt_pk_bf16(oc[et][0], oc[et][1]), cvt_pk_bf16(oc[et][2], oc[et][3])}; *(u32x2*)(OD + qrow * LDK + h * 256 + es * 64 + et * 16 + fq * 4) = w; }
            if (cstep + 1 < nc) RET_LOADQ(cstep + 1);
            if (!sample || cstep + 1 < nc) {
#pragma unroll
            for (int a = 0; a < 2; ++a)
#pragma unroll
                for (int et = 0; et < 4; ++et) st[a][et] *= cdec;
#pragma unroll
            for (int kj = 0; kj < 4; ++kj) {
                bf16x8 uf[6];
#pragma unroll
                for (int et = 0; et < 4; ++et) uf[et] = tr2(VPl + (kj * 32 + 4 * fq + q4) * 160 + et * 32 + 8 * p4, VPl + (kj * 32 + 16 + 4 * fq + q4) * 160 + et * 32 + 8 * p4);
#pragma unroll
                for (int a = 0; a < 2; ++a) uf[4 + a] = tr2(Kl + (kj * 32 + 4 * fq + q4) * 544 + (2 * wid + a) * 32 + 8 * p4, Kl + (kj * 32 + 16 + 4 * fq + q4) * 544 + (2 * wid + a) * 32 + 8 * p4);
                __builtin_amdgcn_sched_barrier(0);
#pragma unroll
                for (int a = 0; a < 2; ++a)
#pragma unroll
                    for (int et = 0; et < 4; ++et) st[a][et] = __builtin_amdgcn_mfma_f32_16x16x32_bf16(uf[et], uf[4 + a], st[a][et], 0, 0, 0);
                __builtin_amdgcn_sched_barrier(0);
            }
            }
            __syncthreads();
        }
#undef RET_LOAD
#undef RET_LOADQ
        if (!sample) {
            float* so = p.out + (dir ? O_RB : O_RF) + (size_t)((b * 2 + li) * 8 + h) * 65536;
#pragma unroll
            for (int a = 0; a < 2; ++a)
#pragma unroll
                for (int et = 0; et < 4; ++et) *(f32x4*)(so + ((2 * wid + a) * 16 + fr) * 256 + es * 64 + et * 16 + fq * 4) = st[a][et];
        }
    }
}

__device__ __forceinline__ void phase_post(const Params& p, int li, unsigned char* smem) {
    const int tid = otid(); const int wid = tid >> 6, lane = tid & 63;
    LAS float* gnl = (LAS float*)smem;
    __syncthreads();
    *(LAS f32x4*)(gnl + tid * 4) = *(const f32x4*)(p.in[22] + li * 2048 + tid * 4);
    __syncthreads();
    const bf16_t* PROJ = (const bf16_t*)(p.ws + WS_PROJ);
    bf16_t* MIX = (bf16_t*)(p.ws + WS_MIX);
    const bf16_t* OF = (const bf16_t*)(p.ws + WS_OF); const bf16_t* OB = (const bf16_t*)(p.ws + WS_OB);
    for (int row = blockIdx.x * 8 + wid; row < NTOK; row += gridDim.x * 8) {
        u32x2 fa[8], fb[8], gg[8];
#pragma unroll
        for (int h = 0; h < 8; ++h) { const size_t off = (size_t)row * LDK + h * 256 + lane * 4;
            fa[h] = __builtin_nontemporal_load((const u32x2*)(OF + off)); fb[h] = __builtin_nontemporal_load((const u32x2*)(OB + off)); gg[h] = __builtin_nontemporal_load((const u32x2*)(PROJ + (size_t)row * LDPO + 6144 + h * 256 + lane * 4)); }
        f32x4 o[8]; float sm[8];
#pragma unroll
        for (int h = 0; h < 8; ++h) {
            o[h] = (f32x4){__uint_as_float(fa[h][0] << 16) + __uint_as_float(fb[h][0] << 16), __uint_as_float(fa[h][0] & 0xffff0000u) + __uint_as_float(fb[h][0] & 0xffff0000u),
                           __uint_as_float(fa[h][1] << 16) + __uint_as_float(fb[h][1] << 16), __uint_as_float(fa[h][1] & 0xffff0000u) + __uint_as_float(fb[h][1] & 0xffff0000u)};
            sm[h] = o[h][0] + o[h][1] + o[h][2] + o[h][3];
        }
#pragma unroll
        for (int sft = 32; sft; sft >>= 1) {
#pragma unroll
            for (int h = 0; h < 8; ++h) sm[h] += __shfl_xor(sm[h], sft);
        }
#pragma unroll
        for (int h = 0; h < 8; ++h) { o[h] -= sm[h] * (1.f / 256.f); sm[h] = o[h][0] * o[h][0] + o[h][1] * o[h][1] + o[h][2] * o[h][2] + o[h][3] * o[h][3]; }
#pragma unroll
        for (int sft = 32; sft; sft >>= 1) {
#pragma unroll
            for (int h = 0; h < 8; ++h) sm[h] += __shfl_xor(sm[h], sft);
        }
#pragma unroll
        for (int h = 0; h < 8; ++h) {
            const float rstd = rsqrtf(sm[h] * (1.f / 256.f) + EPSV);
            const f32x4 g4 = *(const LAS f32x4*)(gnl + h * 256 + lane * 4);
            const float g0 = __uint_as_float(gg[h][0] << 16), g1 = __uint_as_float(gg[h][0] & 0xffff0000u), g2 = __uint_as_float(gg[h][1] << 16), g3 = __uint_as_float(gg[h][1] & 0xffff0000u);
            u32x2 w = {cvt_pk_bf16(o[h][0] * rstd * g4[0] * silu_f(g0), o[h][1] * rstd * g4[1] * silu_f(g1)), cvt_pk_bf16(o[h][2] * rstd * g4[2] * silu_f(g2), o[h][3] * rstd * g4[3] * silu_f(g3))};
            *(u32x2*)(MIX + (size_t)row * LDK + h * 256 + lane * 4) = w;
        }
    }
}

__global__ __launch_bounds__(512) void mega(Params p) {
    __shared__ __attribute__((aligned(16))) unsigned char smem[LDS_BYTES];
    __shared__ uint4 xb_words;
    cg::grid_group grid = cg::this_grid();
    if (threadIdx.x == 0) xb_words = make_uint4(0u, 0u, 0u, 0u);
    __syncthreads();
    XcdBarrier xb; xb.bar = (unsigned*)(p.ws + WS_BAR); xb.x = 0; xb.st = (volatile LAS unsigned*)&xb_words;
    if (p.ph_hi - p.ph_lo > 1) xb = xcd_barrier_post((unsigned*)(p.ws + WS_BAR), (volatile LAS unsigned*)&xb_words);
    bool first = true; int nsync = 0;
#ifndef DUPMASK
#define DUPMASK 0
#endif
#ifndef DUPKIND
#define DUPKIND 15
#endif
    for (int ph2 = p.ph_lo * 2; ph2 < p.ph_hi * 2; ++ph2) {
        const int ph = ph2 >> 1;
        int type, l = 0;
        if (ph == 0) type = 0; else if (ph == 1) type = 1; else if (ph == 22) { type = 2; l = 4; }
        else { l = (ph - 2) / 5; type = 2 + (ph - 2) % 5; }
        if ((type == 5 && !(l & 1)) || type == 1) continue;
        if (ph2 & 1) {
            int bit = type; if (type == 4 && !(l & 1)) bit = 7;
            if (!((DUPMASK >> bit) & 1) || (type == 2 && l >= 2)) continue;
        }
        if (!first) { if (p.ph_lo < 0) grid.sync(); else xcd_barrier(xb); ++nsync; }
        first = false;
        const int li = l >> 1;
        bool do_pre = false; int pa0 = 0, pa1 = 0, ps0 = 0, pc0 = 0, ps1 = 0, pc1 = 0, ps2 = 0, pc2 = 0, ps3 = 0, pc3 = 0, pworker = (int)blockIdx.x, pnw = (int)gridDim.x;
        if (type == 0) { do_pre = true; pa0 = 0; pa1 = 192; ps0 = 0; pc0 = 832; mod_reduce(p, 0, 0, true); }
        else if (type == 2) phase_rows(p, l, smem);
        else if (type == 3) {
            pg8::Gemm g; g.A = (const bf16_t*)(p.ws + WS_H); g.M = NTOK; g.K = DM; g.ld = LDK; pg8::Epi E; E.out = p.out; E.li = li; E.C = (void*)(p.ws + WS_PROJ);
            if (l & 1) { g.Bt = (const bf16_t*)(p.ws + WS_WIO) + (size_t)li * OIN * LDK; g.N = OIN; E.mode = 0; E.ldc = LDPO; }
            else { g.Bt = (const bf16_t*)(p.ws + WS_WIE) + (size_t)li * EIN * LDK; g.N = EIN; E.mode = 1; E.ldc = LDPE; }
            pg8::StaticOrder S; S.init(g.M, g.N, gridDim.x, blockIdx.x);
            pg8::gemm_phase((LAS unsigned char*)smem, g, S, E);
            if (l == 0 || l == 2) {
                const int nfull = 832 % (int)gridDim.x;
                if ((int)blockIdx.x >= nfull) {
                    do_pre = true; pworker = (int)blockIdx.x - nfull; pnw = (int)gridDim.x - nfull;
                    if (l == 0) { pa0 = 192; pa1 = 576; ps0 = 832; pc0 = 832; ps1 = 1664; pc1 = 256; ps2 = 2176; pc2 = 1024; ps3 = 4224; pc3 = 256; }
                    else { pa0 = 576; pa1 = 768; ps0 = 1920; pc0 = 256; ps1 = 3200; pc1 = 1024; ps2 = 4480; pc2 = 256; }
                }
            }
        } else if (type == 4) {
            if (l == 0) mod_reduce(p, 0, 3, false); else if (l == 2) mod_reduce(p, 3, 4, false);
            if (__builtin_amdgcn_readfirstlane((int)threadIdx.x >> 6) >= 4) __builtin_amdgcn_s_setprio(1);
            { const int km = (ph2 & 1) ? DUPKIND : 15; if (l & 1) phase_ret(p, li, smem, km); else phase_attn(p, li, smem, km); }
            __builtin_amdgcn_s_setprio(0);
        } else if (type == 5) phase_post(p, li, smem);
        else {
            pg8::Gemm g; g.A = (const bf16_t*)(p.ws + WS_MIX); g.M = NTOK; g.K = DM; g.ld = LDK; g.N = DM;
            g.Bt = (const bf16_t*)(p.ws + ((l & 1) ? WS_WOO : WS_WOE)) + (size_t)li * DM * LDK;
            pg8::Epi E; E.out = p.out; E.li = li; E.C = (void*)(p.ws + WS_OUT); E.mode = 0; E.ldc = LDK;
            pg8::StaticOrder S; S.init(g.M, g.N, gridDim.x, blockIdx.x);
            pg8::gemm_phase((LAS unsigned char*)smem, g, S, E);
        }
        if (do_pre) pre_work(p, smem, pa0, pa1, ps0, pc0, ps1, pc1, ps2, pc2, ps3, pc3, pworker, pnw);
    }
}

extern "C" void kernel_launch(void* const* d_in, const int* in_sizes, int n_in, void* d_out, int out_size, void* d_ws, size_t ws_size, hipStream_t stream) {
    if (n_in != 23 || ws_size < WS_END) { fprintf(stderr, "kernel_launch: unexpected n_in %d or ws_size %zu (< %zu)\n", n_in, ws_size, (size_t)WS_END); return; }
    Params p{};
    for (int i = 0; i < 23; ++i) p.in[i] = (const float*)d_in[i];
    p.out = (float*)d_out; p.ws = (unsigned char*)d_ws;
    if (hipMemsetAsync((unsigned char*)d_ws + WS_BAR, 0, 3456 * 4, stream) != hipSuccess) { fprintf(stderr, "kernel_launch: memset of the barrier words failed\n"); return; }
#if MULTI_LAUNCH
    for (int ph = 0; ph < NPHASE; ++ph) {
        if (ph >= 2 && ph < 22 && ((ph - 2) % 5) == 3 && (((ph - 2) / 5) & 1) == 0) continue;
        p.ph_lo = ph; p.ph_hi = ph + 1;
        hipLaunchKernelGGL(mega, dim3(256), dim3(512), 0, stream, p);
    }
#else
    static int grid = 0;
    if (!grid) {
        int dev = 0, cus = 0, per_cu = 0;
        (void)hipGetDevice(&dev);
        (void)hipDeviceGetAttribute(&cus, hipDeviceAttributeMultiprocessorCount, dev);
        (void)hipOccupancyMaxActiveBlocksPerMultiprocessor(&per_cu, mega, 512, 0);
        if (per_cu < 1) per_cu = 1;
        if (cus < 1) cus = 256;
        grid = cus * per_cu;
    }
    p.ph_lo = 0; p.ph_hi = NPHASE;
    void* args[] = {&p};
    hipError_t e = hipLaunchCooperativeKernel((void*)mega, dim3(grid), dim3(512), args, 0, stream);
    if (e != hipSuccess) fprintf(stderr, "cooperative launch failed: %s (grid %d)\n", hipGetErrorString(e), grid);
#endif
}
```
